# Optimizing an MI355X kernel written in HIP

```python
import math
import jax
import jax.numpy as jnp
from jax import lax
import numpy as np

D_MODEL = 1024
BATCH = 1
SEQ = 16384
DEPTH = 4
DEC_BATCH = 4
DEC_SEQ = 8192
PAST_LEN = 128

N_MIXERS = 3
GRID_W = 64
PLE_DIM = 256
D_FF = 2816
RMS_EPS = 1e-6

HY_EMB = 33
HY_FILTER_ORDER = 64
HY_SHORT = 3
HY_DECAY_TARGET = 1e-2
HY_DECAY_PCT_HI = 0.3
HY_DECAY_PCT_LO = 1.5

NA_HEADS = 32
NA_HEAD_DIM = D_MODEL // NA_HEADS
NA_KH = 8
NA_KW = 16
NA_QW = 16
NA_KCOLS = 2 * NA_QW
NEG_INF = -1e30

LRU_WIDTH = D_MODEL
LRU_BLOCKS = 4
LRU_BLOCK = LRU_WIDTH // LRU_BLOCKS
LRU_CONV = 4
LRU_C = 8.0

kernel_name = 'hybrid_bidir_hyena_na_rglru_trunk'


def rmsnorm(x, g):
    xf = x.astype(jnp.float32)
    y = xf * lax.rsqrt(jnp.mean(xf * xf, axis=-1, keepdims=True) + RMS_EPS)
    return (y * g.astype(jnp.float32)).astype(x.dtype)


def swiglu(x, w_gate, w_up, w_down):
    return (jax.nn.silu(x @ w_gate) * (x @ w_up)) @ w_down


def depthwise_conv(u, w, b, left):
    width = w.shape[0]
    length = u.shape[1]
    up = jnp.pad(u, ((0, 0), (left, width - 1 - left), (0, 0)))
    y = b + w[0] * up[:, 0:length]
    for j in range(1, width):
        y = y + w[j] * up[:, j:j + length]
    return y


def hyena_filters(length, w1, b1, w2, b2, w3, b3, freq, w_out):
    f32 = jnp.float32
    t = jnp.linspace(0.0, 1.0, length, dtype=f32)[:, None]
    bands = (HY_EMB - 1) // 2
    ang = (2.0 * math.pi / length) * jnp.arange(length, dtype=f32)[:, None]
    fb = jnp.linspace(1e-4, bands - 1, bands, dtype=f32)[None, :]
    z = jnp.concatenate([t, jnp.cos(fb * ang), -jnp.sin(fb * ang)], axis=-1)
    fr = freq.astype(f32)
    h = jnp.sin(fr * (z @ w1.astype(f32) + b1.astype(f32)))
    h = jnp.sin(fr * (h @ w2.astype(f32) + b2.astype(f32)))
    h = jnp.sin(fr * (h @ w3.astype(f32) + b3.astype(f32)))
    k = h @ w_out.astype(f32)
    decay_min = math.log(HY_DECAY_TARGET) / HY_DECAY_PCT_LO
    decay_max = math.log(HY_DECAY_TARGET) / HY_DECAY_PCT_HI
    deltas = jnp.abs(jnp.linspace(decay_min, decay_max, D_MODEL, dtype=f32))
    window = jnp.exp(-t * deltas)
    k = k.reshape(length, 2, D_MODEL) * window[:, None, :]
    return k[:, 0], k[:, 1]


def bidir_long_conv(v, k_fwd, k_bwd):
    length = v.shape[1]
    kc = jnp.concatenate([k_fwd, jnp.zeros((1, D_MODEL), jnp.float32), k_bwd[:0:-1]], axis=0)
    kf = jnp.fft.rfft(kc, axis=0)
    vf = jnp.fft.rfft(v, n=2 * length, axis=1)
    return jnp.fft.irfft(vf * kf[None], n=2 * length, axis=1)[:, :length]


def hyena_mixer(x, prm, j):
    length = x.shape[1]
    u = x @ prm['hy_in_w'][j] + prm['hy_in_b'][j]
    u = depthwise_conv(u, prm['hy_conv_w'][j], prm['hy_conv_b'][j], (HY_SHORT - 1) // 2)
    x0, x1, v = jnp.split(u, 3, axis=-1)
    k_fwd, k_bwd = hyena_filters(length, prm['hy_f_w1'][j], prm['hy_f_b1'][j], prm['hy_f_w2'][j],
                                 prm['hy_f_b2'][j], prm['hy_f_w3'][j], prm['hy_f_b3'][j],
                                 prm['hy_f_freq'][j], prm['hy_f_out'][j])
    v = (v * x1).astype(jnp.float32)
    y = bidir_long_conv(v, k_fwd, k_bwd) + v * prm['hy_skip'][j].astype(jnp.float32)
    y = y.astype(x.dtype) * x0
    return y @ prm['hy_out_w'][j] + prm['hy_out_b'][j]


def na_mixer(x, prm, j):
    f32 = jnp.float32
    bsz, length, _ = x.shape
    rows = length // GRID_W
    kh = min(NA_KH, rows)
    ncb = GRID_W // NA_QW
    qkv = (x @ prm['na_qkv_w'][j] + prm['na_qkv_b'][j]).reshape(bsz, rows, GRID_W, 3, NA_HEADS, NA_HEAD_DIM)
    q = qkv[:, :, :, 0] * (NA_HEAD_DIM ** -0.5)
    k = qkv[:, :, :, 1]
    v = qkv[:, :, :, 2]
    row_start = np.clip(np.arange(rows) - kh // 2, 0, rows - kh)
    cb = np.arange(ncb)
    key_col0 = np.clip(cb * NA_QW - NA_KW // 2, 0, GRID_W - NA_KCOLS)
    key_cols = key_col0[:, None] + np.arange(NA_KCOLS)[None, :]
    q_cols = cb[:, None] * NA_QW + np.arange(NA_QW)[None, :]
    q_start = np.clip(q_cols - NA_KW // 2, 0, GRID_W - NA_KW)
    kc = key_cols[:, None, :]
    col_ok = (kc >= q_start[:, :, None]) & (kc < q_start[:, :, None] + NA_KW)
    dc_idx = np.clip(kc - q_cols[:, :, None] + NA_KW - 1, 0, 2 * NA_KW - 2)
    bias_tab = jnp.where(col_ok[None, None], prm['na_rpb'][j].astype(f32)[:, :, dc_idx], NEG_INF)

    def row_block(args):
        q_r, r, rs = args
        k_r = lax.dynamic_slice_in_dim(k, rs, kh, axis=1)[:, :, key_cols]
        v_r = lax.dynamic_slice_in_dim(v, rs, kh, axis=1)[:, :, key_cols]
        qb = q_r.reshape(bsz, ncb, NA_QW, NA_HEADS, NA_HEAD_DIM)
        s = jnp.einsum('bnqhd,binchd->bhnqic', qb, k_r, preferred_element_type=f32)
        dr_idx = rs + jnp.arange(kh, dtype=jnp.int32) - r + NA_KH - 1
        bias = jnp.take(bias_tab, dr_idx, axis=1).transpose(0, 2, 3, 1, 4)
        s = s + bias[None]
        p = jax.nn.softmax(s.reshape(bsz, NA_HEADS, ncb, NA_QW, kh * NA_KCOLS), axis=-1)
        p = p.reshape(s.shape).astype(v.dtype)
        o = jnp.einsum('bhnqic,binchd->bnqhd', p, v_r)
        return o.reshape(bsz, GRID_W, NA_HEADS, NA_HEAD_DIM)

    o = lax.map(row_block, (jnp.moveaxis(q, 1, 0), jnp.arange(rows, dtype=jnp.int32),
                            jnp.asarray(row_start, dtype=jnp.int32)))
    o = jnp.moveaxis(o, 0, 1).reshape(bsz, length, D_MODEL)
    return o @ prm['na_out_w'][j] + prm['na_out_b'][j]


def _lru_combine(e1, e2):
    a1, b1 = e1
    a2, b2 = e2
    return a1 * a2, a2 * b1 + b2


def rglru_mixer(x, prm, j):
    f32 = jnp.float32
    bsz, length, _ = x.shape
    u = x @ prm['lru_in_w'][j] + prm['lru_in_b'][j]
    gate_branch = jax.nn.gelu(u[..., :LRU_WIDTH])
    xb = depthwise_conv(u[..., LRU_WIDTH:], prm['lru_conv_w'][j], prm['lru_conv_b'][j], LRU_CONV // 2)
    xs = jnp.stack([xb, jnp.flip(xb, axis=1)]).astype(f32)
    xblk = xs.reshape(2, bsz, length, LRU_BLOCKS, LRU_BLOCK)

    def block_diag(w, b):
        y = jnp.einsum('dblnk,dnkj->dblnj', xblk, w.astype(f32)).reshape(2, bsz, length, LRU_WIDTH)
        return y + b.astype(f32)[:, None, None, :]

    gate_x = jax.nn.sigmoid(block_diag(prm['lru_wx'][j], prm['lru_bx'][j]))
    gate_a = jax.nn.sigmoid(block_diag(prm['lru_wa'][j], prm['lru_ba'][j]))
    log_a = -LRU_C * gate_a * jax.nn.softplus(-prm['lru_lambda'][j].astype(f32))[:, None, None, :]
    mult = jnp.sqrt(-jnp.expm1(2.0 * log_a)).at[:, :, 0].set(1.0)
    b = mult * gate_x * xs
    _, h = lax.associative_scan(_lru_combine, (jnp.exp(log_a), b), axis=2)
    y = h[0] + jnp.flip(h[1], axis=1)
    return (gate_branch * y.astype(x.dtype)) @ prm['lru_out_w'][j] + prm['lru_out_b'][j]


def trunk(x, p, prm):
    h = x
    for i in range(DEPTH):
        kind = i % N_MIXERS
        j = i // N_MIXERS
        h = h + 0.5 * swiglu(rmsnorm(h, prm['ln_ffn1'][i]), prm['ffn1_wg'][i], prm['ffn1_wu'][i], prm['ffn1_wd'][i])
        xn = rmsnorm(h, prm['ln_mix'][i])
        if kind == 0:
            m = hyena_mixer(xn, prm, j)
        elif kind == 1:
            m = na_mixer(xn, prm, j)
        else:
            m = rglru_mixer(xn, prm, j)
        h = h + m
        h = h + 0.5 * swiglu(rmsnorm(h, prm['ln_ffn2'][i]), prm['ffn2_wg'][i], prm['ffn2_wu'][i], prm['ffn2_wd'][i])
        gate = jax.nn.sigmoid(rmsnorm(h, prm['ln_ple'][i]) @ prm['ple_gate'][i])
        h = h + gate * (p[i] @ prm['ple_proj'][i])
    return rmsnorm(h, prm['ln_final'])


def setup_inputs(seed: int = 0) -> dict:
    key = jax.random.key(seed)
    keys = jax.random.split(key, 64)
    counter = [0]

    def nxt():
        kk = keys[counter[0]]
        counter[0] += 1
        return kk

    def nrm(shape, scale):
        return scale * jax.random.normal(nxt(), shape, jnp.float32)

    def gain(shape):
        return 1.0 + 0.01 * jax.random.normal(nxt(), shape, jnp.float32)

    n_a = len(range(0, DEPTH, N_MIXERS))
    n_b = len(range(1, DEPTH, N_MIXERS))
    n_c = len(range(2, DEPTH, N_MIXERS))
    d = D_MODEL
    r = LRU_WIDTH
    lam_u = jax.random.uniform(nxt(), (n_c, 2, r), jnp.float32, 0.9, 0.999)
    s = lam_u ** (1.0 / LRU_C)
    lru_lambda = jnp.log(s) - jnp.log1p(-s)
    return {
        'x_prompt': nrm((BATCH, SEQ, d), 1.0),
        'x_sample': nrm((DEC_BATCH, DEC_SEQ, d), 1.0),
        'p_prompt': nrm((DEPTH, BATCH, SEQ, PLE_DIM), 1.0),
        'p_sample': nrm((DEPTH, DEC_BATCH, DEC_SEQ, PLE_DIM), 1.0),
        'ln_ffn1': gain((DEPTH, d)),
        'ffn1_wg': nrm((DEPTH, d, D_FF), d ** -0.5),
        'ffn1_wu': nrm((DEPTH, d, D_FF), d ** -0.5),
        'ffn1_wd': nrm((DEPTH, D_FF, d), D_FF ** -0.5),
        'ln_mix': gain((DEPTH, d)),
        'ln_ffn2': gain((DEPTH, d)),
        'ffn2_wg': nrm((DEPTH, d, D_FF), d ** -0.5),
        'ffn2_wu': nrm((DEPTH, d, D_FF), d ** -0.5),
        'ffn2_wd': nrm((DEPTH, D_FF, d), D_FF ** -0.5),
        'ln_ple': gain((DEPTH, d)),
        'ple_gate': nrm((DEPTH, d, d), d ** -0.5),
        'ple_proj': nrm((DEPTH, PLE_DIM, d), PLE_DIM ** -0.5),
        'ln_final': gain((d,)),
        'hy_in_w': nrm((n_a, d, 3 * d), d ** -0.5),
        'hy_in_b': nrm((n_a, 3 * d), 0.01),
        'hy_conv_w': nrm((n_a, HY_SHORT, 3 * d), HY_SHORT ** -0.5),
        'hy_conv_b': nrm((n_a, 3 * d), 0.01),
        'hy_f_w1': nrm((n_a, HY_EMB, HY_FILTER_ORDER), HY_EMB ** -0.5),
        'hy_f_b1': nrm((n_a, HY_FILTER_ORDER), 0.01),
        'hy_f_w2': nrm((n_a, HY_FILTER_ORDER, HY_FILTER_ORDER), HY_FILTER_ORDER ** -0.5),
        'hy_f_b2': nrm((n_a, HY_FILTER_ORDER), 0.01),
        'hy_f_w3': nrm((n_a, HY_FILTER_ORDER, HY_FILTER_ORDER), HY_FILTER_ORDER ** -0.5),
        'hy_f_b3': nrm((n_a, HY_FILTER_ORDER), 0.01),
        'hy_f_freq': gain((n_a, HY_FILTER_ORDER)),
        'hy_f_out': nrm((n_a, HY_FILTER_ORDER, 2 * d), 0.02),
        'hy_skip': nrm((n_a, d), 1.0),
        'hy_out_w': nrm((n_a, d, d), d ** -0.5),
        'hy_out_b': nrm((n_a, d), 0.01),
        'na_qkv_w': nrm((n_b, d, 3 * d), d ** -0.5),
        'na_qkv_b': nrm((n_b, 3 * d), 0.01),
        'na_rpb': nrm((n_b, NA_HEADS, 2 * NA_KH - 1, 2 * NA_KW - 1), 0.02),
        'na_out_w': nrm((n_b, d, d), d ** -0.5),
        'na_out_b': nrm((n_b, d), 0.01),
        'lru_in_w': nrm((n_c, d, 2 * r), d ** -0.5),
        'lru_in_b': nrm((n_c, 2 * r), 0.01),
        'lru_conv_w': nrm((n_c, LRU_CONV, r), LRU_CONV ** -0.5),
        'lru_conv_b': nrm((n_c, r), 0.01),
        'lru_wa': nrm((n_c, 2, LRU_BLOCKS, LRU_BLOCK, LRU_BLOCK), LRU_BLOCK ** -0.5),
        'lru_ba': nrm((n_c, 2, r), 0.01),
        'lru_wx': nrm((n_c, 2, LRU_BLOCKS, LRU_BLOCK, LRU_BLOCK), LRU_BLOCK ** -0.5),
        'lru_bx': nrm((n_c, 2, r), 0.01),
        'lru_lambda': lru_lambda,
        'lru_out_w': nrm((n_c, r, d), r ** -0.5),
        'lru_out_b': nrm((n_c, d), 0.01),
    }


def reference(x_prompt, x_sample, p_prompt, p_sample,
              ln_ffn1, ffn1_wg, ffn1_wu, ffn1_wd, ln_mix, ln_ffn2, ffn2_wg, ffn2_wu, ffn2_wd,
              ln_ple, ple_gate, ple_proj, ln_final,
              hy_in_w, hy_in_b, hy_conv_w, hy_conv_b, hy_f_w1, hy_f_b1, hy_f_w2, hy_f_b2,
              hy_f_w3, hy_f_b3, hy_f_freq, hy_f_out, hy_skip, hy_out_w, hy_out_b,
              na_qkv_w, na_qkv_b, na_rpb, na_out_w, na_out_b,
              lru_in_w, lru_in_b, lru_conv_w, lru_conv_b, lru_wa, lru_ba, lru_wx, lru_bx,
              lru_lambda, lru_out_w, lru_out_b):
    prm = {
        'ln_ffn1': ln_ffn1, 'ffn1_wg': ffn1_wg, 'ffn1_wu': ffn1_wu, 'ffn1_wd': ffn1_wd,
        'ln_mix': ln_mix, 'ln_ffn2': ln_ffn2, 'ffn2_wg': ffn2_wg, 'ffn2_wu': ffn2_wu, 'ffn2_wd': ffn2_wd,
        'ln_ple': ln_ple, 'ple_gate': ple_gate, 'ple_proj': ple_proj, 'ln_final': ln_final,
        'hy_in_w': hy_in_w, 'hy_in_b': hy_in_b, 'hy_conv_w': hy_conv_w, 'hy_conv_b': hy_conv_b,
        'hy_f_w1': hy_f_w1, 'hy_f_b1': hy_f_b1, 'hy_f_w2': hy_f_w2, 'hy_f_b2': hy_f_b2,
        'hy_f_w3': hy_f_w3, 'hy_f_b3': hy_f_b3, 'hy_f_freq': hy_f_freq, 'hy_f_out': hy_f_out,
        'hy_skip': hy_skip, 'hy_out_w': hy_out_w, 'hy_out_b': hy_out_b,
        'na_qkv_w': na_qkv_w, 'na_qkv_b': na_qkv_b, 'na_rpb': na_rpb, 'na_out_w': na_out_w, 'na_out_b': na_out_b,
        'lru_in_w': lru_in_w, 'lru_in_b': lru_in_b, 'lru_conv_w': lru_conv_w, 'lru_conv_b': lru_conv_b,
        'lru_wa': lru_wa, 'lru_ba': lru_ba, 'lru_wx': lru_wx, 'lru_bx': lru_bx,
        'lru_lambda': lru_lambda, 'lru_out_w': lru_out_w, 'lru_out_b': lru_out_b,
    }
    y_prompt = trunk(x_prompt, p_prompt, prm)
    y_sample = trunk(x_sample, p_sample, prm)
    return (y_prompt, y_sample)
```

```cpp
#include <hip/hip_runtime.h>
#include <hip/hip_cooperative_groups.h>
#include <cstdio>
namespace cg = cooperative_groups;

#define LAS __attribute__((address_space(3)))
typedef unsigned short bf16_t;
typedef short bf16x8 __attribute__((ext_vector_type(8)));
typedef float f32x4 __attribute__((ext_vector_type(4)));
typedef float f32x2 __attribute__((ext_vector_type(2)));
typedef float f32x16 __attribute__((ext_vector_type(16)));
typedef unsigned u32x4 __attribute__((ext_vector_type(4)));
typedef unsigned u32x2 __attribute__((ext_vector_type(2)));

#ifndef PROBE
#define PROBE 0
#endif
constexpr int D = 1024, DFF = 2816, TP = 16384, TS = 32768, T = TP + TS, LS = 8192, PLE = 256;
constexpr int NTHR = 512;
constexpr float EPS = 1e-6f;
constexpr size_t MiB = 1u << 20;
constexpr size_t UB = (size_t)T * D * 2;
constexpr size_t WS_WGU1 = 0, WS_WD1 = 11 * MiB, WS_WGU2 = WS_WD1 + 11 * MiB / 2, WS_WD2 = WS_WGU2 + 11 * MiB, WS_WPG = 33 * MiB, WS_WPP = 35 * MiB,
                 WS_WMI = WS_WPP + MiB / 2, WS_WMO = WS_WMI + 6 * MiB, WS_WLG = WS_WMO + 2 * MiB, WS_SMALL = WS_WLG + 2 * MiB, WS_RSS = 46 * MiB,
                 WS_AGG = 50 * MiB, WS_S1 = 62 * MiB, WS_M1 = WS_S1 + 3 * UB, WS_M2 = WS_M1 + UB, WS_M3 = WS_M2 + UB, WS_RSS2 = WS_M3 + UB, WS_BAR = WS_RSS2 + 7 * MiB, WS_CAR = WS_RSS2 + 8 * MiB, WS_END = WS_CAR + 6 * MiB;
constexpr int TAB_OFF = 143360, LDS_BYTES = 147456;

struct Params { const float* in[48]; float* out; unsigned char* ws; };

__device__ __forceinline__ unsigned cvt_pk_bf16(float lo, float hi) { unsigned r; asm volatile("v_cvt_pk_bf16_f32 %0, %1, %2" : "=v"(r) : "v"(lo), "v"(hi)); return r; }
__device__ __forceinline__ float bflo(unsigned w) { return __uint_as_float(w << 16); }
__device__ __forceinline__ float bfhi(unsigned w) { return __uint_as_float(w & 0xffff0000u); }
__device__ __forceinline__ float bf2f(bf16_t b) { return __uint_as_float(((unsigned)b) << 16); }
__device__ __forceinline__ bf16_t f2bf(float f) { return (bf16_t)(cvt_pk_bf16(f, 0.f) & 0xffffu); }
__device__ __forceinline__ float fast_sigmoid(float x) { return __builtin_amdgcn_rcpf(1.0f + __builtin_amdgcn_exp2f(-1.44269504089f * x)); }
__device__ __forceinline__ float fast_exp(float x) { return __builtin_amdgcn_exp2f(1.44269504089f * x); }
__device__ __forceinline__ float hw_sin(float x) { return __builtin_amdgcn_sinf(x * 0.15915494309189535f); }
__device__ __forceinline__ float hw_cos(float x) { return __builtin_amdgcn_cosf(x * 0.15915494309189535f); }
__device__ __forceinline__ float fast_tanh(float y) { return 1.0f - 2.0f * __builtin_amdgcn_rcpf(1.0f + __builtin_amdgcn_exp2f(2.88539008178f * y)); }

namespace pg8 {
constexpr int BM = 256, BK = 64, HALF = 128, HTB = HALF * BK * 2, STAGE_BYTES = 8 * HTB, NXCD = 8, WGM = 8;
__host__ __device__ __forceinline__ int lds_byte(int r, int c) { const int st = (r >> 4) * 2 + (c >> 5), rr = r & 15, cc = c & 31, ob = rr * 64 + cc * 2; return st * 1024 + (ob ^ (((ob >> 9) & 1) << 5)); }
__host__ __device__ __forceinline__ void stage_rc(int b, int& R, int& C) { const int st = b / 1024, sb = b % 1024, swz = sb ^ (((sb >> 9) & 1) << 5); R = (st >> 1) * 16 + swz / 64; C = (st & 1) * 32 + (swz % 64) / 2; }
__host__ __device__ __forceinline__ int perm32(int rho) { const int n = rho >> 4, i = rho & 15; return 8 * (i >> 2) + 4 * n + (i & 3); }

struct Unit { int pm, pn; };
struct Gemm { const bf16_t* A; const bf16_t* Bt; int M, N, K, lda, ldb, agrp; };

struct StaticOrder {
    int nM, nN, nwg, G, c, rev;
    __host__ __device__ void init(int M, int N, int G_, int c_) { nM = M / BM; nN = N / BM; nwg = nM * nN; G = G_; c = c_; rev = 0; }
    __host__ __device__ bool next(int i, Unit& u) const {
        const int L = i * G + c; if (L >= nwg) return false;
        int wgid = L; { const int q = nwg / NXCD, r = nwg % NXCD, xcd = wgid % NXCD, off = wgid / NXCD; wgid = (xcd < r ? xcd * (q + 1) : r * (q + 1) + (xcd - r) * q) + off; }
        const int nig = WGM * nN, gid = wgid / nig, fm = gid * WGM, gsz = (nM - fm) < WGM ? (nM - fm) : WGM;
        u.pm = fm + ((wgid % nig) % gsz); u.pn = (wgid % nig) / gsz; if (rev) u.pm = nM - 1 - u.pm; return true;
    }
};

template <class Epi, int KK, int LDA, int LDB, int NN, bool AGRP>
__device__ __forceinline__ void gemm_phase(LAS unsigned char* lds, const bf16_t* gA, const bf16_t* gBt, int G_, int bid_, int tid) {
    const Epi E{};
    struct { const bf16_t* A; const bf16_t* Bt; int lda, ldb, agrp; } g{gA, gBt, LDA, LDB, AGRP ? 1 : 0};
    StaticOrder S; S.init(49152, NN, G_, bid_); S.rev = (KK == 2816) ? 1 : 0;
    const int wid = __builtin_amdgcn_readfirstlane(tid >> 6), lane = tid & 63, wr = wid >> 2, wc = wid & 3, fr = lane & 15, fq = lane >> 4;
    constexpr int K = KK, nt = K / BK;
    unsigned voffA[2], voffB[2];
#pragma unroll
    for (int i = 0; i < 2; ++i) { int R, C; stage_rc(tid * 16 + i * 8192, R, C); const int Rb = Epi::PERM ? ((R & ~31) + perm32(R & 31)) : R;
        voffA[i] = (unsigned)(R * g.lda + C) * 2u; voffB[i] = (unsigned)(Rb * g.ldb + C) * 2u; }
    const size_t kstep = (size_t)(BK * 2);
    constexpr size_t hstepA = (size_t)HALF * LDA * 2, hstepB = (size_t)HALF * LDB * 2;
    constexpr size_t tstepA = 2 * hstepA, tstepB = 2 * hstepB;
    const unsigned ldsw = (unsigned)wid * 1024u;
    const int aoff = lds_byte(wr * 64 + fr, fq * 8), boff = lds_byte(wc * 32 + fr, fq * 8);
#define PG8_SA(b, h) (((b) * 2 + (h)) * HTB)
#define PG8_SB(b, h) ((4 + (b) * 2 + (h)) * HTB)
#define PG8_STAGE(bufoff, gbase, voff) do { _Pragma("unroll") for (int _i = 0; _i < 2; ++_i) \
        __builtin_amdgcn_global_load_lds((const unsigned*)((const char*)(gbase) + (voff)[_i]), (LAS unsigned*)(lds + (bufoff) + ldsw + _i * 8192), 16, 0, 0); } while (0)
#define PG8_LDA(dst, b, h) do { _Pragma("unroll") for (int m = 0; m < 4; ++m) _Pragma("unroll") for (int k = 0; k < 2; ++k) dst[m][k] = *(const LAS bf16x8*)(lds + PG8_SA(b, h) + aoff + m * 2048 + k * 1024); } while (0)
#define PG8_LDB(dst, b, h) do { _Pragma("unroll") for (int n = 0; n < 2; ++n) _Pragma("unroll") for (int k = 0; k < 2; ++k) dst[n][k] = *(const LAS bf16x8*)(lds + PG8_SB(b, h) + boff + n * 2048 + k * 1024); } while (0)
#define PG8_MMA(ai, bj, At, Bt) do { __builtin_amdgcn_s_setprio(1); _Pragma("unroll") for (int m = 0; m < 4; ++m) _Pragma("unroll") for (int n = 0; n < 2; ++n) _Pragma("unroll") for (int k = 0; k < 2; ++k) \
        acc[ai][bj][m][n] = __builtin_amdgcn_mfma_f32_16x16x32_bf16(Bt[n][k], At[m][k], acc[ai][bj][m][n], 0, 0, 0); __builtin_amdgcn_s_setprio(0); } while (0)
#define PG8_WAIT_V(n) asm volatile("s_waitcnt vmcnt(" #n ")" ::: "memory")
#define PG8_WAIT_L(n) asm volatile("s_waitcnt lgkmcnt(" #n ")" ::: "memory")
#define PG8_BAR __builtin_amdgcn_s_barrier()
#define PG8_SCHED __builtin_amdgcn_sched_barrier(0)
#define PG8_ACOL(pn) (AGRP ? (size_t)((((pn) >> 1) & 3) * 512) : (size_t)0)
    Unit cur, nxt; int ui = 0;
    if (!S.next(0, cur)) return;
    float zr = 0.f; asm volatile("" : "+v"(zr));
    f32x4 acc[2][2][4][2];
#pragma unroll
    for (int a = 0; a < 2; ++a)
#pragma unroll
        for (int b = 0; b < 2; ++b)
#pragma unroll
            for (int m = 0; m < 4; ++m)
#pragma unroll
                for (int n = 0; n < 2; ++n) acc[a][b][m][n] = (f32x4){zr, zr, zr, zr};
    bf16x8 At[4][2], B0[2][2], B1[2][2];
    const char* cA = (const char*)g.A + (size_t)cur.pm * tstepA + PG8_ACOL(cur.pn); const char* cB = (const char*)g.Bt + (size_t)cur.pn * tstepB;
    PG8_STAGE(PG8_SB(0, 0), cB, voffB); PG8_STAGE(PG8_SA(0, 0), cA, voffA); PG8_STAGE(PG8_SB(0, 1), cB + hstepB, voffB); PG8_STAGE(PG8_SA(0, 1), cA + hstepA, voffA);
    if (wr == 1) PG8_BAR;
    PG8_WAIT_V(4); PG8_BAR;
    PG8_STAGE(PG8_SB(1, 0), cB + kstep, voffB); PG8_STAGE(PG8_SA(1, 0), cA + kstep, voffA); PG8_STAGE(PG8_SB(1, 1), cB + hstepB + kstep, voffB);
    PG8_WAIT_V(6); PG8_BAR;
    for (;;) {
        const bool has_next = S.next(ui + 1, nxt);
        const char* nA = has_next ? (const char*)g.A + (size_t)nxt.pm * tstepA + PG8_ACOL(nxt.pn) : cA; const char* nB = has_next ? (const char*)g.Bt + (size_t)nxt.pn * tstepB : cB;
#pragma nounroll
        for (int t = 0; t < nt; t += 2) {
            const bool last = (t == nt - 2);
            const char* a1 = cA + (size_t)(t + 1) * kstep;
            const char* a2 = last ? nA : cA + (size_t)(t + 2) * kstep; const char* b2 = last ? nB : cB + (size_t)(t + 2) * kstep;
            const char* a3 = a2 + kstep; const char* b3 = b2 + kstep;
            PG8_LDB(B0, 0, 0); PG8_SCHED; PG8_LDA(At, 0, 0); PG8_STAGE(PG8_SA(1, 1), a1 + hstepA, voffA);
            PG8_WAIT_L(8); PG8_BAR; PG8_WAIT_L(0); PG8_MMA(0, 0, At, B0); PG8_BAR; PG8_SCHED;
            PG8_LDB(B1, 0, 1); PG8_STAGE(PG8_SB(0, 0), b2, voffB);
            PG8_BAR; PG8_WAIT_L(0); PG8_MMA(0, 1, At, B1); PG8_BAR;
            PG8_LDA(At, 0, 1); PG8_STAGE(PG8_SA(0, 0), a2, voffA);
            PG8_BAR; PG8_WAIT_L(0); PG8_MMA(1, 0, At, B0); PG8_BAR; PG8_SCHED;
            PG8_STAGE(PG8_SB(0, 1), b2 + hstepB, voffB);
            PG8_WAIT_V(6); PG8_BAR; PG8_MMA(1, 1, At, B1); PG8_BAR;
            PG8_LDB(B0, 1, 0); PG8_SCHED; PG8_LDA(At, 1, 0); PG8_STAGE(PG8_SA(0, 1), a2 + hstepA, voffA);
            PG8_WAIT_L(8); PG8_BAR; PG8_WAIT_L(0); PG8_MMA(0, 0, At, B0); PG8_BAR; PG8_SCHED;
            PG8_LDB(B1, 1, 1); PG8_STAGE(PG8_SB(1, 0), b3, voffB);
            PG8_BAR; PG8_WAIT_L(0); PG8_MMA(0, 1, At, B1); PG8_BAR;
            PG8_LDA(At, 1, 1); PG8_STAGE(PG8_SA(1, 0), a3, voffA);
            PG8_BAR; PG8_WAIT_L(0); PG8_MMA(1, 0, At, B0); PG8_BAR; PG8_SCHED;
            PG8_STAGE(PG8_SB(1, 1), b3 + hstepB, voffB);
            PG8_WAIT_V(6); PG8_BAR; PG8_MMA(1, 1, At, B1); PG8_BAR;
        }
        E(acc, cur, wr, wc, fr, fq, lds);
        if (!has_next) break;
#pragma unroll
        for (int a = 0; a < 2; ++a)
#pragma unroll
            for (int b = 0; b < 2; ++b)
#pragma unroll
                for (int m = 0; m < 4; ++m)
#pragma unroll
                    for (int n = 0; n < 2; ++n) acc[a][b][m][n] = (f32x4){zr, zr, zr, zr};
        cur = nxt; cA = nA; cB = nB; ++ui;
    }
    PG8_WAIT_V(0);
    if (wr == 0) PG8_BAR;
    PG8_BAR;
#undef PG8_SA
#undef PG8_SB
#undef PG8_STAGE
#undef PG8_LDA
#undef PG8_LDB
#undef PG8_MMA
#undef PG8_WAIT_V
#undef PG8_WAIT_L
#undef PG8_BAR
#undef PG8_SCHED
#undef PG8_ACOL
}

__device__ __forceinline__ float rstd_of(const float* rss, int row) {
    const f32x4* p = (const f32x4*)(rss + (size_t)row * 16); const f32x4 a = p[0], b = p[1], c = p[2], d = p[3];
    const float s = ((a[0] + a[1]) + (a[2] + a[3])) + ((b[0] + b[1]) + (b[2] + b[3])) + (((c[0] + c[1]) + (c[2] + c[3])) + ((d[0] + d[1]) + (d[2] + d[3])));
    return rsqrtf(s * (1.0f / 1024.0f) + EPS); }
__device__ __forceinline__ float rstd_of4(const float* rss, int row, int fq) {
    const f32x4 a = *(const f32x4*)(rss + (size_t)row * 16 + 4 * fq); float s = (a[0] + a[1]) + (a[2] + a[3]);
    s += __shfl_xor(s, 16); s += __shfl_xor(s, 32);
    return rsqrtf(s * (1.0f / 1024.0f) + EPS); }
__device__ __forceinline__ unsigned long long ep64(LAS unsigned char* lds, int k) {
    volatile LAS unsigned* t = (volatile LAS unsigned*)(lds + TAB_OFF + 1024); unsigned lo = t[2 * k], hi = t[2 * k + 1];
    lo = __builtin_amdgcn_readfirstlane(lo); hi = __builtin_amdgcn_readfirstlane(hi); return ((unsigned long long)hi << 32) | (unsigned long long)lo; }
#define EPP(T_, k) ((T_)(__attribute__((address_space(1))) char*)ep64(lds, (k)))

struct EpiSwiGLU {
    static constexpr bool PERM = true;
    __device__ __forceinline__ void operator()(const f32x4 (&acc)[2][2][4][2], const Unit& u, int wr, int wc, int fr, int fq, LAS unsigned char* lds) const {
        bf16_t* O = EPP(bf16_t*, 0); const float* rss = EPP(const float*, 1);
        const int row0 = u.pm * BM + wr * 64 + fr, j0 = u.pn * 128 + wc * 32 + 8 * fq;
        const bool early = (u.pm % 24) < 8;
#pragma unroll
        for (int ai = 0; ai < 2; ++ai)
#pragma unroll
            for (int m = 0; m < 4; ++m) { const int row = row0 + ai * HALF + m * 16; const float rs = rstd_of4(rss, row, fq);
                float h[8];
#pragma unroll
                for (int n = 0; n < 2; ++n)
#pragma unroll
                    for (int e = 0; e < 4; ++e) { const float gt = acc[ai][0][m][n][e] * rs, up = acc[ai][1][m][n][e] * rs; h[n * 4 + e] = gt * fast_sigmoid(gt) * up; }
                u32x4 w; w.x = cvt_pk_bf16(h[0], h[1]); w.y = cvt_pk_bf16(h[2], h[3]); w.z = cvt_pk_bf16(h[4], h[5]); w.w = cvt_pk_bf16(h[6], h[7]);
                if (early) __builtin_nontemporal_store(w, (u32x4*)(O + (size_t)row * DFF + j0)); else *(u32x4*)(O + (size_t)row * DFF + j0) = w; }
    }
};
struct EpiProj {
    static constexpr bool PERM = true;
    __device__ __forceinline__ void operator()(const f32x4 (&acc)[2][2][4][2], const Unit& u, int wr, int wc, int fr, int fq, LAS unsigned char* lds) const {
        bf16_t* O = EPP(bf16_t*, 0); const float* rss = EPP(const float*, 1); const float* bias = EPP(const float*, 2); const int ldc = (int)ep64(lds, 3);
        const int row0 = u.pm * BM + wr * 64 + fr, col0 = u.pn * BM + wc * 32 + 8 * fq;
        f32x4 bv[2][2];
#pragma unroll
        for (int bj = 0; bj < 2; ++bj)
#pragma unroll
            for (int n = 0; n < 2; ++n) bv[bj][n] = bias ? *(const f32x4*)(bias + col0 + bj * HALF + 4 * n) : (f32x4){0.f, 0.f, 0.f, 0.f};
#pragma unroll
        for (int ai = 0; ai < 2; ++ai)
#pragma unroll
            for (int m = 0; m < 4; ++m) { const int row = row0 + ai * HALF + m * 16; const float rs = rss ? rstd_of4(rss, row, fq) : 1.0f;
#pragma unroll
                for (int bj = 0; bj < 2; ++bj) { const f32x4 v0 = acc[ai][bj][m][0] * rs + bv[bj][0], v1 = acc[ai][bj][m][1] * rs + bv[bj][1];
                    u32x4 w; w.x = cvt_pk_bf16(v0[0], v0[1]); w.y = cvt_pk_bf16(v0[2], v0[3]); w.z = cvt_pk_bf16(v1[0], v1[1]); w.w = cvt_pk_bf16(v1[2], v1[3]);
                    *(u32x4*)(O + (size_t)row * ldc + col0 + bj * HALF) = w; } }
    }
};
template <int MODE> struct EpiResid {
    static constexpr bool PERM = true;
    __device__ __forceinline__ void operator()(const f32x4 (&acc)[2][2][4][2], const Unit& u, int wr, int wc, int fr, int fq, LAS unsigned char* lds) const {
        const float* rss_in = EPP(const float*, 1); const float* bias = EPP(const float*, 2);
        const bf16_t* base = EPP(const bf16_t*, 3);
        bf16_t* hb = EPP(bf16_t*, 5); float* rss_out = EPP(float*, 6); const bf16_t* pp = EPP(const bf16_t*, 7); const float scale = __uint_as_float((unsigned)ep64(lds, 8));
        const int row0 = u.pm * BM + wr * 64 + fr, col0 = u.pn * BM + wc * 32 + 8 * fq;
        f32x4 bv[2][2];
#pragma unroll
        for (int bj = 0; bj < 2; ++bj)
#pragma unroll
            for (int n = 0; n < 2; ++n) bv[bj][n] = (MODE == 0 && bias) ? *(const f32x4*)(bias + col0 + bj * HALF + 4 * n) : (f32x4){0.f, 0.f, 0.f, 0.f};
#pragma unroll
        for (int ai = 0; ai < 2; ++ai)
#pragma unroll
            for (int m = 0; m < 4; ++m) { const int row = row0 + ai * HALF + m * 16; const size_t off = (size_t)row * D + col0;
                float rs = 1.0f; if (MODE == 1) rs = rstd_of4(rss_in, row, fq);
                float ss = 0.f;
#pragma unroll
                for (int bj = 0; bj < 2; ++bj) { const size_t o = off + bj * HALF; const u32x4 bw = *(const u32x4*)(base + o);
                    const float bs[8] = {bflo(bw.x), bfhi(bw.x), bflo(bw.y), bfhi(bw.y), bflo(bw.z), bfhi(bw.z), bflo(bw.w), bfhi(bw.w)};
                    float hn[8];
                    if (MODE == 0) {
#pragma unroll
                        for (int n = 0; n < 2; ++n)
#pragma unroll
                            for (int e = 0; e < 4; ++e) hn[4 * n + e] = bs[4 * n + e] + (acc[ai][bj][m][n][e] + bv[bj][n][e]) * scale;
                    } else { const u32x4 pw = *(const u32x4*)(pp + o);
                        const float pv[8] = {bflo(pw.x), bfhi(pw.x), bflo(pw.y), bfhi(pw.y), bflo(pw.z), bfhi(pw.z), bflo(pw.w), bfhi(pw.w)};
#pragma unroll
                        for (int n = 0; n < 2; ++n)
#pragma unroll
                            for (int e = 0; e < 4; ++e) hn[4 * n + e] = bs[4 * n + e] + fast_sigmoid(acc[ai][bj][m][n][e] * rs) * pv[4 * n + e]; }
                    u32x4 w; w.x = cvt_pk_bf16(hn[0], hn[1]); w.y = cvt_pk_bf16(hn[2], hn[3]); w.z = cvt_pk_bf16(hn[4], hn[5]); w.w = cvt_pk_bf16(hn[6], hn[7]); *(u32x4*)(hb + o) = w;
                    const float hr[8] = {bflo(w.x), bfhi(w.x), bflo(w.y), bfhi(w.y), bflo(w.z), bfhi(w.z), bflo(w.w), bfhi(w.w)};
                    ss += ((hr[0] * hr[0] + hr[1] * hr[1]) + (hr[2] * hr[2] + hr[3] * hr[3])) + ((hr[4] * hr[4] + hr[5] * hr[5]) + (hr[6] * hr[6] + hr[7] * hr[7])); }
                ss += __shfl_xor(ss, 16); ss += __shfl_xor(ss, 32);
                if (fq == 0) rss_out[(size_t)row * 16 + u.pn * 4 + wc] = ss; }
    }
};
struct EpiLruGates {
    static constexpr bool PERM = true;
    __device__ __forceinline__ void operator()(const f32x4 (&acc)[2][2][4][2], const Unit& u, int wr, int wc, int fr, int fq, LAS unsigned char* lds) const {
        const int grp = u.pn >> 1, d = grp >> 2, blk = grp & 3, c0 = blk * 256 + (u.pn & 1) * 128 + wc * 32 + 8 * fq;
        const int row0 = u.pm * BM + wr * 64 + fr;
        const bf16_t* xb = EPP(const bf16_t*, 0); bf16_t* LA = EPP(bf16_t*, 1 + d); bf16_t* BB = EPP(bf16_t*, 3 + d);
        const float* bx = EPP(const float*, 5); const float* ba = EPP(const float*, 6); const float* lsp = EPP(const float*, 7);
        f32x4 vbx[2], vba[2], vls[2];
#pragma unroll
        for (int n = 0; n < 2; ++n) { vbx[n] = *(const f32x4*)(bx + d * D + c0 + 4 * n); vba[n] = *(const f32x4*)(ba + d * D + c0 + 4 * n); vls[n] = *(const f32x4*)(lsp + d * D + c0 + 4 * n); }
#pragma unroll
        for (int ai = 0; ai < 2; ++ai)
#pragma unroll
            for (int m = 0; m < 4; ++m) { const int row = row0 + ai * HALF + m * 16; const size_t o = (size_t)row * D + c0;
                const bool first = d == 0 ? ((row & (LS - 1)) == 0 && row != LS) : ((row & (LS - 1)) == LS - 1 && row != LS - 1);
                const u32x4 xw = *(const u32x4*)(xb + o);
                const float xv[8] = {bflo(xw.x), bfhi(xw.x), bflo(xw.y), bfhi(xw.y), bflo(xw.z), bfhi(xw.z), bflo(xw.w), bfhi(xw.w)};
                float lo[8], bo[8];
#pragma unroll
                for (int n = 0; n < 2; ++n)
#pragma unroll
                    for (int e = 0; e < 4; ++e) { const int qd = 4 * n + e; const float gx = fast_sigmoid(acc[ai][0][m][n][e] + vbx[n][e]), ga = fast_sigmoid(acc[ai][1][m][n][e] + vba[n][e]);
                        const float l = ga * vls[n][e]; const float mult = first ? 1.0f : __builtin_amdgcn_sqrtf(fmaxf(1.0f - fast_exp(2.0f * l), 0.f)); lo[qd] = l; bo[qd] = mult * gx * xv[qd]; }
                u32x4 w; w.x = cvt_pk_bf16(lo[0], lo[1]); w.y = cvt_pk_bf16(lo[2], lo[3]); w.z = cvt_pk_bf16(lo[4], lo[5]); w.w = cvt_pk_bf16(lo[6], lo[7]); *(u32x4*)(LA + o) = w;
                w.x = cvt_pk_bf16(bo[0], bo[1]); w.y = cvt_pk_bf16(bo[2], bo[3]); w.z = cvt_pk_bf16(bo[4], bo[5]); w.w = cvt_pk_bf16(bo[6], bo[7]); *(u32x4*)(BB + o) = w; }
    }
};
#undef EPP
}


#define XB_TMO      128
#define XB_XCNT(j)  (256  + 64 * (j))
#define XB_XSUB(j)  (1280 + 64 * (j))
#define XB_XGEN(j)  (2304 + 64 * (j))
#define XB_TOP      3328
#define XB_TOPGEN   3392
#define XCD_BAR_WORDS 3456
#define XB_SPIN_CAP (1u << 22)
__device__ __forceinline__ unsigned xb_ld(unsigned* p)              { return __hip_atomic_load(p, __ATOMIC_RELAXED, __HIP_MEMORY_SCOPE_AGENT); }
__device__ __forceinline__ unsigned xb_add(unsigned* p, unsigned v) { return __hip_atomic_fetch_add(p, v, __ATOMIC_RELAXED, __HIP_MEMORY_SCOPE_AGENT); }
__device__ __forceinline__ unsigned xb_xcc_id() { return (unsigned)__builtin_amdgcn_s_getreg((3 << 11) | 20) & 0xFu; }
#define XB_SPIN(cond, bar) do { unsigned _sp = 0; while (cond) { __builtin_amdgcn_s_sleep(1); \
    if ((++_sp & 255u) == 0u) { if (xb_ld(&(bar)[XB_TMO])) break; if (_sp > XB_SPIN_CAP) { atomicAdd(&(bar)[XB_TMO], 1u); break; } } } } while (0)
__device__ __forceinline__ void xcd_barrier_complete(unsigned* bar, unsigned x, unsigned& nloc, unsigned& nx) {
    const unsigned G = gridDim.x * gridDim.y * gridDim.z;
    unsigned sum, cnt, mine, sp = 0u;
    for (;;) {
        sum = 0u; cnt = 0u; mine = 0u;
#pragma unroll
        for (unsigned j = 0; j < 16; ++j) { const unsigned c = xb_ld(&bar[XB_XCNT(j)]); sum += c; cnt += (c > 0u) ? 1u : 0u; mine = (j == x) ? c : mine; }
        if (sum == G) break;
        __builtin_amdgcn_s_sleep(1);
        if ((++sp & 255u) == 0u) { if (xb_ld(&bar[XB_TMO])) break; if (sp > XB_SPIN_CAP) { atomicAdd(&bar[XB_TMO], 1u); break; } }
    }
    nloc = mine > 0u ? mine : 1u; nx = cnt > 0u ? cnt : 1u;
}
__device__ __forceinline__ void xcd_barrier(unsigned* bar, volatile LAS unsigned* st) {
    asm volatile("s_waitcnt vmcnt(0)" ::: "memory");
    __syncthreads();
    if (threadIdx.x == 0) {
        const unsigned x = xb_xcc_id();
        __builtin_amdgcn_s_waitcnt(0);
        unsigned nloc = st[0], nx = st[1];
        if (nloc == 0u) { xcd_barrier_complete(bar, x, nloc, nx); st[0] = nloc; st[1] = nx; }
        const unsigned old = xb_add(&bar[XB_XSUB(x)], 1u);
        const unsigned gen = old / nloc;
        if (old + 1u == (gen + 1u) * nloc) {
            __builtin_amdgcn_fence(__ATOMIC_RELEASE, "agent");
            asm volatile("s_waitcnt vmcnt(0)" ::: "memory");
            const unsigned og = xb_add(&bar[XB_TOP], 1u);
            const unsigned tg = og / nx;
            if (og + 1u == (tg + 1u) * nx) xb_add(&bar[XB_TOPGEN], 1u);
            else XB_SPIN(xb_ld(&bar[XB_TOPGEN]) == tg, bar);
            __builtin_amdgcn_fence(__ATOMIC_ACQUIRE, "agent");
            xb_add(&bar[XB_XGEN(x)], 1u);
            asm volatile("s_waitcnt vmcnt(0)" ::: "memory");
        } else {
            XB_SPIN(xb_ld(&bar[XB_XGEN(x)]) == gen, bar);
            __builtin_amdgcn_fence(__ATOMIC_ACQUIRE, "agent");
            asm volatile("s_waitcnt vmcnt(0)" ::: "memory");
        }
    }
    __syncthreads();
}

struct Ctx { int tid, lane, wave, bid, nblk; LAS unsigned char* lds; };

__device__ __forceinline__ void convT(const Ctx& c, const float* W, int K, int N, int ldw, const float* gain, bf16_t* dst, int ldd, int G, int S, int off) {
    LAS float* tile = (LAS float*)c.lds;
    const int nk = K / 64, nn = N / 256, njobs = nk * nn;
    for (int job = c.bid; job < njobs; job += c.nblk) {
        const int kt = job / nn, ntile = job % nn, k0 = kt * 64, n0 = ntile * 256;
        f32x4 v[8];
#pragma unroll
        for (int i = 0; i < 8; ++i) { const int e = c.tid + i * NTHR, kk = e >> 6, n4 = (e & 63) * 4; v[i] = *(const f32x4*)(W + (size_t)(k0 + kk) * ldw + n0 + n4); if (gain) v[i] = v[i] * gain[k0 + kk]; }
        __syncthreads();
#pragma unroll
        for (int i = 0; i < 8; ++i) { const int e = c.tid + i * NTHR, kk = e >> 6, n4 = (e & 63) * 4; LAS float* tp = tile + kk * 257 + n4; tp[0] = v[i][0]; tp[1] = v[i][1]; tp[2] = v[i][2]; tp[3] = v[i][3]; }
        __syncthreads();
#pragma unroll
        for (int i = 0; i < 4; ++i) { const int e = c.tid + i * NTHR, n = e & 255, ks = (e >> 8) * 8;
            float x[8];
#pragma unroll
            for (int j = 0; j < 8; ++j) x[j] = tile[(ks + j) * 257 + n];
            u32x4 w; w.x = cvt_pk_bf16(x[0], x[1]); w.y = cvt_pk_bf16(x[2], x[3]); w.z = cvt_pk_bf16(x[4], x[5]); w.w = cvt_pk_bf16(x[6], x[7]);
            const int ng = n0 + n, drow = (ng / G) * S + (ng % G) + off;
            *(u32x4*)(dst + (size_t)drow * ldd + k0 + ks) = w; }
    }
    __syncthreads();
}

__device__ __forceinline__ void x_to_bf16(const Ctx& c, const float* xp, const float* xs, bf16_t* hb, float* rss) {
    const int gw = c.bid * 8 + c.wave, nw = c.nblk * 8;
    for (int row0 = gw * 2; row0 < T; row0 += nw * 2) {
        f32x4 v[2][4];
#pragma unroll
        for (int rr = 0; rr < 2; ++rr) { const int row = row0 + rr; const float* src = row < TP ? xp + (size_t)row * D : xs + (size_t)(row - TP) * D;
#pragma unroll
            for (int i = 0; i < 4; ++i) v[rr][i] = *(const f32x4*)(src + i * 256 + c.lane * 4); }
#pragma unroll
        for (int rr = 0; rr < 2; ++rr) { const int row = row0 + rr; float ss = 0.f;
#pragma unroll
            for (int i = 0; i < 4; ++i) { u32x2 w; w.x = cvt_pk_bf16(v[rr][i][0], v[rr][i][1]); w.y = cvt_pk_bf16(v[rr][i][2], v[rr][i][3]); *(u32x2*)(hb + (size_t)row * D + i * 256 + c.lane * 4) = w;
                const float a0 = bflo(w.x), a1 = bfhi(w.x), a2 = bflo(w.y), a3 = bfhi(w.y); ss += (a0 * a0 + a1 * a1) + (a2 * a2 + a3 * a3); }
#pragma unroll
            for (int o = 32; o >= 1; o >>= 1) ss += __shfl_xor(ss, o);
            if (c.lane < 16) rss[(size_t)row * 16 + c.lane] = c.lane == 0 ? ss : 0.f; }
    }
}
__device__ __forceinline__ void p_to_bf16(const Ctx& c, const float* pp_, const float* ps_, bf16_t* dst) {
    const size_t n8 = (size_t)T * PLE / 8, np8 = (size_t)TP * PLE / 8, stride = (size_t)c.nblk * NTHR;
    for (size_t i0 = (size_t)c.bid * NTHR + c.tid; i0 < n8; i0 += 4 * stride) {
        f32x4 a[4], b[4];
#pragma unroll
        for (int k = 0; k < 4; ++k) { const size_t i = i0 + k * stride; if (i < n8) { const float* src = i < np8 ? pp_ + i * 8 : ps_ + (i - np8) * 8; a[k] = *(const f32x4*)src; b[k] = *(const f32x4*)(src + 4); } }
#pragma unroll
        for (int k = 0; k < 4; ++k) { const size_t i = i0 + k * stride; if (i < n8) {
            u32x4 w; w.x = cvt_pk_bf16(a[k][0], a[k][1]); w.y = cvt_pk_bf16(a[k][2], a[k][3]); w.z = cvt_pk_bf16(b[k][0], b[k][1]); w.w = cvt_pk_bf16(b[k][2], b[k][3]);
            *(u32x4*)(dst + i * 8) = w; } }
    }
}
__device__ __forceinline__ void zero_f32(const Ctx& c, float* p, size_t n) {
    for (size_t i = ((size_t)c.bid * NTHR + c.tid) * 4; i < n; i += (size_t)c.nblk * NTHR * 4) *(f32x4*)(p + i) = (f32x4){0.f, 0.f, 0.f, 0.f};
}
__device__ __forceinline__ void seq_of(int row, int& s0, int& L) { if (row < TP) { s0 = 0; L = TP; } else { s0 = TP + ((row - TP) & ~(LS - 1)); L = LS; } }

__device__ __forceinline__ void hy_elem(const Ctx& c, const bf16_t* u, const float* cw, const float* cb, bf16_t* vv, bf16_t* x0c, bf16_t* vvT) {
    LAS bf16_t* tile = (LAS bf16_t*)c.lds;
    const int tr = c.tid >> 3, cg = c.tid & 7;
    for (int job = c.bid; job < (T / 256) * 16; job += c.nblk) {
        const int c0 = (job & 15) * 64, ch = c0 + cg * 8, rowj = (job >> 4) * 256;
        float wgt[3][3][8], bia[3][8];
#pragma unroll
        for (int part = 0; part < 3; ++part) { const int col = part * D + ch;
#pragma unroll
            for (int h2 = 0; h2 < 2; ++h2) { const f32x4 b4 = *(const f32x4*)(cb + col + 4 * h2);
#pragma unroll
                for (int e = 0; e < 4; ++e) bia[part][4 * h2 + e] = b4[e];
#pragma unroll
                for (int tap = 0; tap < 3; ++tap) { const f32x4 w4 = *(const f32x4*)(cw + tap * 3072 + col + 4 * h2);
#pragma unroll
                    for (int e = 0; e < 4; ++e) wgt[part][tap][4 * h2 + e] = w4[e]; } } }
        for (int tl = 0; tl < 4; ++tl) {
            const int row0 = rowj + tl * 64, row = row0 + tr;
            int s0, L; seq_of(row, s0, L); const bool hasp = row > s0, hasn = row < s0 + L - 1;
            float r[3][8];
#pragma unroll
            for (int part = 0; part < 3; ++part) { const int col = part * D + ch; const bf16_t* p = u + (size_t)row * 3072 + col;
                const u32x4 z4 = (u32x4){0u, 0u, 0u, 0u};
                const u32x4 wc_ = *(const u32x4*)p, wp = hasp ? *(const u32x4*)(p - 3072) : z4, wn = hasn ? *(const u32x4*)(p + 3072) : z4;
                const unsigned wcv[4] = {wc_.x, wc_.y, wc_.z, wc_.w}, wpv[4] = {wp.x, wp.y, wp.z, wp.w}, wnv[4] = {wn.x, wn.y, wn.z, wn.w};
#pragma unroll
                for (int e = 0; e < 4; ++e) {
                    r[part][2 * e] = bia[part][2 * e] + wgt[part][0][2 * e] * bflo(wpv[e]) + wgt[part][1][2 * e] * bflo(wcv[e]) + wgt[part][2][2 * e] * bflo(wnv[e]);
                    r[part][2 * e + 1] = bia[part][2 * e + 1] + wgt[part][0][2 * e + 1] * bfhi(wpv[e]) + wgt[part][1][2 * e + 1] * bfhi(wcv[e]) + wgt[part][2][2 * e + 1] * bfhi(wnv[e]); } }
            u32x4 w; w.x = cvt_pk_bf16(r[0][0], r[0][1]); w.y = cvt_pk_bf16(r[0][2], r[0][3]); w.z = cvt_pk_bf16(r[0][4], r[0][5]); w.w = cvt_pk_bf16(r[0][6], r[0][7]);
            *(u32x4*)(x0c + (size_t)row * D + ch) = w;
            w.x = cvt_pk_bf16(r[2][0] * r[1][0], r[2][1] * r[1][1]); w.y = cvt_pk_bf16(r[2][2] * r[1][2], r[2][3] * r[1][3]);
            w.z = cvt_pk_bf16(r[2][4] * r[1][4], r[2][5] * r[1][5]); w.w = cvt_pk_bf16(r[2][6] * r[1][6], r[2][7] * r[1][7]);
                __syncthreads();
            { const unsigned wv[4] = {w.x, w.y, w.z, w.w};
#pragma unroll
              for (int e = 0; e < 4; ++e) { tile[(cg * 8 + 2 * e) * 74 + tr] = (bf16_t)(wv[e] & 0xffffu); tile[(cg * 8 + 2 * e + 1) * 74 + tr] = (bf16_t)(wv[e] >> 16); } }
            __syncthreads();
            { const int cc = c.tid >> 3, tg = c.tid & 7; const LAS unsigned* tp = (const LAS unsigned*)(tile + cc * 74 + tg * 8); u32x4 v; v.x = tp[0]; v.y = tp[1]; v.z = tp[2]; v.w = tp[3];
              *(u32x4*)(vvT + (size_t)(c0 + cc) * T + row0 + tg * 8) = v; }
        }
    }
    __syncthreads();
}
__device__ __forceinline__ void hy_final(const Ctx& c, const bf16_t* yT, const bf16_t* vv, const bf16_t* x0c, const float* skip, bf16_t* yg) {
    LAS bf16_t* tile = (LAS bf16_t*)c.lds;
    for (int job = c.bid; job < (T / 64) * 16; job += c.nblk) {
        const int row0 = (job >> 4) * 64, c0 = (job & 15) * 64;
        __syncthreads();
        { const int cc = c.tid >> 3, tg = c.tid & 7; const u32x4 v = *(const u32x4*)(yT + (size_t)(c0 + cc) * T + row0 + tg * 8); const unsigned wv[4] = {v.x, v.y, v.z, v.w};
#pragma unroll
          for (int e = 0; e < 4; ++e) { tile[(tg * 8 + 2 * e) * 74 + cc] = (bf16_t)(wv[e] & 0xffffu); tile[(tg * 8 + 2 * e + 1) * 74 + cc] = (bf16_t)(wv[e] >> 16); } }
        __syncthreads();
        const int tr = c.tid >> 3, cg = c.tid & 7, row = row0 + tr, ch = c0 + cg * 8; const size_t o = (size_t)row * D + ch;
        const LAS unsigned* tp = (const LAS unsigned*)(tile + tr * 74 + cg * 8); u32x4 yv; yv.x = tp[0]; yv.y = tp[1]; yv.z = tp[2]; yv.w = tp[3];
        const u32x4 xw = *(const u32x4*)(x0c + o);
        u32x4 w;
        w.x = cvt_pk_bf16(bflo(yv.x) * bflo(xw.x), bfhi(yv.x) * bfhi(xw.x));
        w.y = cvt_pk_bf16(bflo(yv.y) * bflo(xw.y), bfhi(yv.y) * bfhi(xw.y));
        w.z = cvt_pk_bf16(bflo(yv.z) * bflo(xw.z), bfhi(yv.z) * bfhi(xw.z));
        w.w = cvt_pk_bf16(bflo(yv.w) * bflo(xw.w), bfhi(yv.w) * bfhi(xw.w));
        *(u32x4*)(yg + o) = w;
    }
    __syncthreads();
}
__device__ __forceinline__ void hy_filter(const Ctx& c, int L, size_t kbase, const float* w1, const float* b1, const float* w2, const float* b2, const float* w3, const float* b3,
                                          const float* freq, const bf16_t* woutB, const float* skip, bf16_t* FK) {
    const int lane = c.lane, wave = c.wave, r = lane & 31, h = lane >> 5;
    LAS bf16_t* h3b = (LAS bf16_t*)c.lds;
    const float fr = freq[lane], vb1 = b1[lane], vb2 = b2[lane], vb3 = b3[lane];
    const float dmin = -3.0701134573253945f, dmax = -15.350567286626972f;
    for (int job = c.bid; job < L / 32; job += c.nblk) {
        const int tb = job * 32, t0 = tb + wave * 4;
        float z[4];
#pragma unroll
        for (int tt = 0; tt < 4; ++tt) { const int t = t0 + tt; float v = 0.f;
            if (lane == 0) v = (float)t / (float)(L - 1);
            else if (lane <= 32) { const int bi = (lane - 1) & 15; const float fb = 1e-4f + (float)bi * ((15.0f - 1e-4f) / 15.0f); const float ang = (6.283185307179586f / (float)L) * (float)t; const float a = fb * ang;
                v = lane <= 16 ? hw_cos(a) : -hw_sin(a); }
            z[tt] = v; }
        float hh[4], a[4];
#pragma unroll
        for (int tt = 0; tt < 4; ++tt) a[tt] = vb1;
        for (int i = 0; i < 33; ++i) { const float w = w1[i * 64 + lane];
#pragma unroll
            for (int tt = 0; tt < 4; ++tt) a[tt] += __shfl(z[tt], i) * w; }
#pragma unroll
        for (int tt = 0; tt < 4; ++tt) { hh[tt] = hw_sin(fr * a[tt]); a[tt] = vb2; }
        for (int i = 0; i < 64; ++i) { const float w = w2[i * 64 + lane];
#pragma unroll
            for (int tt = 0; tt < 4; ++tt) a[tt] += __shfl(hh[tt], i) * w; }
#pragma unroll
        for (int tt = 0; tt < 4; ++tt) { hh[tt] = hw_sin(fr * a[tt]); a[tt] = vb3; }
        for (int i = 0; i < 64; ++i) { const float w = w3[i * 64 + lane];
#pragma unroll
            for (int tt = 0; tt < 4; ++tt) a[tt] += __shfl(hh[tt], i) * w; }
        __syncthreads();
#pragma unroll
        for (int tt = 0; tt < 4; ++tt) h3b[(wave * 4 + tt) * 72 + lane] = f2bf(hw_sin(fr * a[tt]));
        __syncthreads();
        bf16x8 Bf[4];
#pragma unroll
        for (int s = 0; s < 4; ++s) Bf[s] = *(const LAS bf16x8*)(h3b + r * 72 + 16 * s + 8 * h);
        const int t = tb + r; const float tn = (float)t / (float)(L - 1);
        for (int nt = 0; nt < 8; ++nt) {
            const int n0 = wave * 256 + nt * 32;
            bf16x8 Af[4];
#pragma unroll
            for (int s = 0; s < 4; ++s) Af[s] = *(const bf16x8*)(woutB + (size_t)(n0 + r) * 64 + 16 * s + 8 * h);
            f32x16 acc;
#pragma unroll
            for (int i = 0; i < 16; ++i) acc[i] = 0.f;
#pragma unroll
            for (int s = 0; s < 4; ++s) acc = __builtin_amdgcn_mfma_f32_32x32x16_bf16(Af[s], Bf[s], acc, 0, 0, 0);
            const int dir = n0 >> 10;
#pragma unroll
            for (int i = 0; i < 16; ++i) { const int n = n0 + (i & 3) + 8 * (i >> 2) + 4 * h, ch = n & 1023;
                const float delta = fabsf(dmin + (float)ch * ((dmax - dmin) / 1023.0f));
                const bool zero = (dir == 1 && t == 0); const int idx = dir == 0 ? L - t : (zero ? 0 : L + t);
                FK[kbase + (size_t)ch * 2 * L + idx] = zero ? (bf16_t)0 : f2bf(acc[i] * fast_exp(-tn * delta) + ((dir == 0 && t == 0) ? skip[ch] : 0.f)); }
        }
    }
    __syncthreads();
}
template <int RHO> __device__ __forceinline__ u32x4 kr_shift(const u32x4 lo, const u32x4 hi) {
    const unsigned d[8] = {lo.x, lo.y, lo.z, lo.w, hi.x, hi.y, hi.z, hi.w};
    u32x4 o; unsigned ov[4];
#pragma unroll
    for (int k = 0; k < 4; ++k) {
        if (RHO % 2 == 0) ov[k] = d[4 - RHO / 2 + k];
        else ov[k] = __builtin_amdgcn_alignbit(d[4 - (RHO - 1) / 2 + k], d[3 - (RHO - 1) / 2 + k], 16);
    }
    o.x = ov[0]; o.y = ov[1]; o.z = ov[2]; o.w = ov[3]; return o;
}
template <bool PROMPT>
__device__ __forceinline__ void longconv_item(const Ctx& c, int ch, const bf16_t* vvT, const bf16_t* KR, bf16_t* yT) {
    constexpr int L = PROMPT ? TP : LS, NB = L / 256, NSEQ = PROMPT ? 1 : 4, VLEN = L + 768;
    constexpr int KB_OFF = NSEQ * VLEN * 2, KB_BYTES = (2 * L + (2 * L / 256) * 8) * 2, RB_OFF = KB_OFF + KB_BYTES;
    constexpr int NSTEPS = (L + 256) / 16, KSPLIT = PROMPT ? 8 : 4, PER = NSTEPS / KSPLIT;
    static_assert(RB_OFF + 32768 <= TAB_OFF && NSTEPS % KSPLIT == 0 && PER % 2 == 0, "long-conv LDS map");
    LAS unsigned char* lds = c.lds;
    const bf16_t* kr = KR + (PROMPT ? (size_t)ch * (2 * TP) : (size_t)D * (2 * TP) + (size_t)ch * (2 * LS));
    const size_t tok0 = (size_t)ch * T + (PROMPT ? 0 : TP);
    const int lane = c.lane, wave = c.wave, r = lane & 31, h = lane >> 5;
    __syncthreads();
#pragma unroll
    for (int s = 0; s < NSEQ; ++s) {
        for (int i = c.tid; i < 96; i += NTHR) { const int idx = i < 32 ? i * 8 : 256 + L + (i - 32) * 8; *(LAS u32x4*)(lds + (s * VLEN + idx) * 2) = (u32x4){0u, 0u, 0u, 0u}; }
        for (int i = c.tid; i < L / 8; i += NTHR) *(LAS u32x4*)(lds + (s * VLEN + 256 + i * 8) * 2) = *(const u32x4*)(vvT + tok0 + (size_t)s * L + i * 8);
    }
    constexpr int NG = 2 * L / 8 / NTHR;
    u32x4 klo[NG], khi[NG];
#pragma unroll
    for (int k = 0; k < NG; ++k) { const int X0 = (c.tid + NTHR * k) * 8; khi[k] = *(const u32x4*)(kr + X0); klo[k] = (u32x4){0u, 0u, 0u, 0u}; if (X0 >= 8) klo[k] = *(const u32x4*)(kr + X0 - 8); }
#define KR_STAGE(R) _Pragma("unroll") for (int k = 0; k < NG; ++k) { const int X0 = (c.tid + NTHR * k) * 8; *(LAS u32x4*)(lds + KB_OFF + (X0 + (X0 >> 8) * 8) * 2) = kr_shift<R>(klo[k], khi[k]); }
    float yst[4]; unsigned ywd[4];
    for (int rho = 0; rho < 8; ++rho) {
        __syncthreads();
        switch (rho) { case 0: { KR_STAGE(0) } break; case 1: { KR_STAGE(1) } break; case 2: { KR_STAGE(2) } break; case 3: { KR_STAGE(3) } break;
                       case 4: { KR_STAGE(4) } break; case 5: { KR_STAGE(5) } break; case 6: { KR_STAGE(6) } break; default: { KR_STAGE(7) } break; }
        __syncthreads();
        f32x16 acc0, acc1;
#pragma unroll
        for (int i = 0; i < 16; ++i) { acc0[i] = 0.f; acc1[i] = 0.f; }
        const int q = PROMPT ? wave : (wave & 3), p = PROMPT ? 0 : (wave >> 2);
        if (PROMPT) {
            const int bb = (8 * r + 8 * h) * 2, ab0 = KB_OFF + (264 * (NB - r - 1) + 8 * h) * 2, ab1 = KB_OFF + (264 * (NB - 32 - r - 1) + 8 * h) * 2;
#define LC_LD(X, Y, Z, ST) { const int kp_ = 16 * (ST), ao_ = 2 * (kp_ + 8 * (kp_ >> 8)), bo_ = 2 * kp_; X = *(const LAS bf16x8*)(lds + bb + bo_); Y = *(const LAS bf16x8*)(lds + ab0 + ao_); Z = *(const LAS bf16x8*)(lds + ab1 + ao_); }
            const int st0 = q * PER, st1 = st0 + PER;
            bf16x8 Ba, A0a, A1a, Bb, A0b, A1b;
            LC_LD(Ba, A0a, A1a, st0);
            for (int st = st0; st < st1; st += 2) {
                LC_LD(Bb, A0b, A1b, st + 1);
                acc0 = __builtin_amdgcn_mfma_f32_32x32x16_bf16(A0a, Ba, acc0, 0, 0, 0); acc1 = __builtin_amdgcn_mfma_f32_32x32x16_bf16(A1a, Ba, acc1, 0, 0, 0);
                { const int sn = st + 2 < st1 ? st + 2 : st1 - 1; LC_LD(Ba, A0a, A1a, sn); }
                acc0 = __builtin_amdgcn_mfma_f32_32x32x16_bf16(A0b, Bb, acc0, 0, 0, 0); acc1 = __builtin_amdgcn_mfma_f32_32x32x16_bf16(A1b, Bb, acc1, 0, 0, 0);
            }
#undef LC_LD
        } else {
            const int ab = KB_OFF + (264 * (NB - r - 1) + 8 * h) * 2, bb0 = ((2 * p) * VLEN + 8 * r + 8 * h) * 2, bb1 = ((2 * p + 1) * VLEN + 8 * r + 8 * h) * 2;
#define LC_LD(X, Y, Z, ST) { const int kp_ = 16 * (ST), ao_ = 2 * (kp_ + 8 * (kp_ >> 8)), bo_ = 2 * kp_; X = *(const LAS bf16x8*)(lds + ab + ao_); Y = *(const LAS bf16x8*)(lds + bb0 + bo_); Z = *(const LAS bf16x8*)(lds + bb1 + bo_); }
            const int st0 = q * PER, st1 = st0 + PER;
            bf16x8 Aa, B0a, B1a, Ab, B0b, B1b;
            LC_LD(Aa, B0a, B1a, st0);
            for (int st = st0; st < st1; st += 2) {
                LC_LD(Ab, B0b, B1b, st + 1);
                acc0 = __builtin_amdgcn_mfma_f32_32x32x16_bf16(Aa, B0a, acc0, 0, 0, 0); acc1 = __builtin_amdgcn_mfma_f32_32x32x16_bf16(Aa, B1a, acc1, 0, 0, 0);
                { const int sn = st + 2 < st1 ? st + 2 : st1 - 1; LC_LD(Aa, B0a, B1a, sn); }
                acc0 = __builtin_amdgcn_mfma_f32_32x32x16_bf16(Ab, B0b, acc0, 0, 0, 0); acc1 = __builtin_amdgcn_mfma_f32_32x32x16_bf16(Ab, B1b, acc1, 0, 0, 0);
            }
#undef LC_LD
        }
        LAS float* rb = (LAS float*)(lds + RB_OFF);
#pragma unroll
        for (int j = 0; j < 2; ++j) {
#pragma unroll
            for (int i = 0; i < 16; ++i) rb[wave * 1024 + i * 64 + lane] = j == 0 ? acc0[i] : acc1[i];
            __syncthreads();
            if (PROMPT) {
#pragma unroll
                for (int k2 = 0; k2 < 2; ++k2) { const int e = c.tid + NTHR * k2, v = j * 2 + k2; float s = 0.f;
#pragma unroll
                    for (int w = 0; w < 8; ++w) s += rb[w * 1024 + e];
                    if ((rho & 1) == 0) yst[v] = s;
                    else { const unsigned pw = cvt_pk_bf16(yst[v], s);
                        if ((rho & 2) == 0) ywd[v] = pw;
                        else { const int i = e >> 6, l = e & 63, m = (i & 3) + 8 * (i >> 2) + 4 * (l >> 5), n = l & 31, t0 = 256 * (32 * j + m) + 8 * n + (rho & 4);
                            *(u32x2*)((char*)yT + ((unsigned)tok0 + (unsigned)t0) * 2u) = (u32x2){ywd[v], pw}; } } }
            } else {
#pragma unroll
                for (int k2 = 0; k2 < 4; ++k2) { const int idx = c.tid + NTHR * k2, pp = idx >> 10, e = idx & 1023; float s = 0.f;
#pragma unroll
                    for (int w = 0; w < 4; ++w) s += rb[(pp * 4 + w) * 1024 + e];
                    const int i = e >> 6, l = e & 63, m = (i & 3) + 8 * (i >> 2) + 4 * (l >> 5), n = l & 31, t = 256 * m + 8 * n + rho;
                    yT[tok0 + (size_t)(2 * pp + j) * L + t] = f2bf(s); }
            }
            __syncthreads();
        }
    }
}
#undef KR_STAGE
__device__ __forceinline__ void longconv_sample2(const Ctx& c, int ch, const bf16_t* vvT, const bf16_t* KR, bf16_t* yT) {
    constexpr int L = LS, NB = L / 256, NSEQ = 4, VLEN = L + 768;
    constexpr int KB_OFF = NSEQ * VLEN * 2, KB_BYTES = (2 * L + (2 * L / 256) * 8) * 2;
    constexpr int NSTEPS = (L + 256) / 16, PER = NSTEPS / 4;
    static_assert(KB_OFF + 2 * KB_BYTES <= TAB_OFF && KB_BYTES >= 32768 && NSTEPS % 4 == 0 && PER % 2 == 0, "long-conv LDS map (sample)");
    LAS unsigned char* lds = c.lds;
    const bf16_t* kr = KR + (size_t)D * (2 * TP) + (size_t)ch * (2 * LS);
    const size_t tok0 = (size_t)ch * T + TP;
    const int lane = c.lane, wave = c.wave, r = lane & 31, h = lane >> 5;
    __syncthreads();
#pragma unroll
    for (int s = 0; s < NSEQ; ++s) {
        for (int i = c.tid; i < 96; i += NTHR) { const int idx = i < 32 ? i * 8 : 256 + L + (i - 32) * 8; *(LAS u32x4*)(lds + (s * VLEN + idx) * 2) = (u32x4){0u, 0u, 0u, 0u}; }
        for (int i = c.tid; i < L / 8; i += NTHR) *(LAS u32x4*)(lds + (s * VLEN + 256 + i * 8) * 2) = *(const u32x4*)(vvT + tok0 + (size_t)s * L + i * 8);
    }
    constexpr int NG = 2 * L / 8 / NTHR;
    u32x4 klo[NG], khi[NG];
#pragma unroll
    for (int k = 0; k < NG; ++k) { const int X0 = (c.tid + NTHR * k) * 8; khi[k] = *(const u32x4*)(kr + X0); klo[k] = (u32x4){0u, 0u, 0u, 0u}; if (X0 >= 8) klo[k] = *(const u32x4*)(kr + X0 - 8); }
    float yst[8]; unsigned ywd[8];
#define KR_STAGE2(R) _Pragma("unroll") for (int k = 0; k < NG; ++k) { const int X0 = (c.tid + NTHR * k) * 8, P_ = (X0 + (X0 >> 8) * 8) * 2; \
        *(LAS u32x4*)(lds + KB_OFF + P_) = kr_shift<R>(klo[k], khi[k]); *(LAS u32x4*)(lds + KB_OFF + KB_BYTES + P_) = kr_shift<R + 1>(klo[k], khi[k]); }
    for (int rp = 0; rp < 4; ++rp) {
        __syncthreads();
        switch (rp) { case 0: { KR_STAGE2(0) } break; case 1: { KR_STAGE2(2) } break; case 2: { KR_STAGE2(4) } break; default: { KR_STAGE2(6) } break; }
        __syncthreads();
        f32x16 acc00, acc01, acc10, acc11;
#pragma unroll
        for (int i = 0; i < 16; ++i) { acc00[i] = 0.f; acc01[i] = 0.f; acc10[i] = 0.f; acc11[i] = 0.f; }
        const int q = wave & 3, p = wave >> 2;
        const int aba = KB_OFF + (264 * (NB - r - 1) + 8 * h) * 2, abb = aba + KB_BYTES, bb0 = ((2 * p) * VLEN + 8 * r + 8 * h) * 2, bb1 = ((2 * p + 1) * VLEN + 8 * r + 8 * h) * 2;
#define LC_LD(W, X, Y, Z, ST) { const int kp_ = 16 * (ST), ao_ = 2 * (kp_ + 8 * (kp_ >> 8)), bo_ = 2 * kp_; W = *(const LAS bf16x8*)(lds + aba + ao_); X = *(const LAS bf16x8*)(lds + abb + ao_); \
            Y = *(const LAS bf16x8*)(lds + bb0 + bo_); Z = *(const LAS bf16x8*)(lds + bb1 + bo_); }
#define LC_MM(W, X, Y, Z) { acc00 = __builtin_amdgcn_mfma_f32_32x32x16_bf16(W, Y, acc00, 0, 0, 0); acc01 = __builtin_amdgcn_mfma_f32_32x32x16_bf16(W, Z, acc01, 0, 0, 0); \
            acc10 = __builtin_amdgcn_mfma_f32_32x32x16_bf16(X, Y, acc10, 0, 0, 0); acc11 = __builtin_amdgcn_mfma_f32_32x32x16_bf16(X, Z, acc11, 0, 0, 0); }
        const int st0 = q * PER, st1 = st0 + PER;
        bf16x8 Aa0, Ab0, B00, B10, Aa1, Ab1, B01, B11;
        LC_LD(Aa0, Ab0, B00, B10, st0);
        for (int st = st0; st < st1; st += 2) {
            LC_LD(Aa1, Ab1, B01, B11, st + 1);
            LC_MM(Aa0, Ab0, B00, B10);
            { const int sn = st + 2 < st1 ? st + 2 : st1 - 1; LC_LD(Aa0, Ab0, B00, B10, sn); }
            LC_MM(Aa1, Ab1, B01, B11);
        }
#undef LC_LD
#undef LC_MM
        __syncthreads();
        LAS float* rb = (LAS float*)(lds + KB_OFF);
        static_assert(2 * KB_BYTES >= 65536, "reduce buffer must fit in the two filter copies");
#pragma unroll
        for (int rr = 0; rr < 2; ++rr) {
            if (rr) __syncthreads();
#pragma unroll
            for (int i = 0; i < 16; ++i) { rb[wave * 2048 + i * 64 + lane] = rr == 0 ? acc00[i] : acc10[i]; rb[wave * 2048 + 1024 + i * 64 + lane] = rr == 0 ? acc01[i] : acc11[i]; }
            __syncthreads();
#pragma unroll
            for (int k2 = 0; k2 < 4; ++k2)
#pragma unroll
                for (int sb = 0; sb < 2; ++sb) { const int idx = c.tid + NTHR * k2, pp = idx >> 10, e = idx & 1023, v = k2 * 2 + sb; float s = 0.f;
#pragma unroll
                    for (int w = 0; w < 4; ++w) s += rb[(pp * 4 + w) * 2048 + sb * 1024 + e];
                    if (rr == 0) yst[v] = s;
                    else { const unsigned pw = cvt_pk_bf16(yst[v], s);
                        if ((rp & 1) == 0) ywd[v] = pw;
                        else { const int i = e >> 6, l = e & 63, m = (i & 3) + 8 * (i >> 2) + 4 * (l >> 5), n = l & 31, t0 = 256 * m + 8 * n + 2 * (rp & 2);
                            *(u32x2*)((char*)yT + ((unsigned)tok0 + (unsigned)((2 * pp + sb) * L + t0)) * 2u) = (u32x2){ywd[v], pw}; } } }
        }
    }
#undef KR_STAGE2
}
__device__ __forceinline__ void hy_longconv(const Ctx& c, const bf16_t* vvT, const bf16_t* KR, bf16_t* yT) {
    for (int item = c.bid; item < 2 * D; item += c.nblk) {
        if (item < D) longconv_item<true>(c, item, vvT, KR, yT); else longconv_sample2(c, item - D, vvT, KR, yT);
    }
    __syncthreads();
}

__device__ __forceinline__ float dpp_xor1(float x) { return __int_as_float(__builtin_amdgcn_update_dpp(0, __float_as_int(x), 0xB1, 0xF, 0xF, true)); }
__device__ __forceinline__ float dpp_xor2(float x) { return __int_as_float(__builtin_amdgcn_update_dpp(0, __float_as_int(x), 0x4E, 0xF, 0xF, true)); }
__device__ __forceinline__ void na_attn(const Ctx& c, const bf16_t* qkv, const float* rpb, bf16_t* o) {
    LAS unsigned char* KV = c.lds;
    LAS bf16_t* VT = (LAS bf16_t*)(c.lds + 40960);
    constexpr int VP = 52, VH = 32 * VP + 8;
    LAS float* rp = (LAS float*)(c.lds + 40960 + 16 * VH * 2);
    int hh_loaded = -1;
    const int ql = c.lane & 31, h = c.lane >> 5;
    const bool xmap = false; const int nsteps = (3072 + c.nblk - 1) / c.nblk;
    for (int stp = 0; stp < nsteps; ++stp) {
        int hh, ch2, grow;
        if (xmap) { const int x = c.bid & 7, lb = c.bid >> 3; grow = 96 * x + 8 * stp + (lb >> 2); hh = (lb >> 1) & 1; ch2 = lb & 1; }
        else { const int it = c.bid + stp * c.nblk; if (it >= 3072) break; grow = it >> 2; hh = (it >> 1) & 1; ch2 = it & 1; }
        if (hh != hh_loaded) { __syncthreads(); for (int i = c.tid; i < 16 * 15 * 31; i += NTHR) rp[i] = rpb[hh * (16 * 15 * 31) + i] * 1.44269504089f; hh_loaded = hh; }
        const int row_tok = grow * 64; int s0, L; seq_of(row_tok, s0, L);
        const int rows = L / 64, r = (row_tok - s0) / 64;
        int rs = r - 4; rs = rs < 0 ? 0 : (rs > rows - 8 ? rows - 8 : rs);
        const int kcb0 = ch2 ? 24 : 0;
        const int qc = ch2 * 32 + ql; int qsl = qc - 8; qsl = qsl < 0 ? 0 : (qsl > 48 ? 48 : qsl);
        bf16x8 Qf[2][2]; f32x16 O[2]; float mrun[2], lrun[2];
#pragma unroll
        for (int e = 0; e < 2; ++e) { const int hd = hh * 16 + 2 * c.wave + e;
#pragma unroll
            for (int s = 0; s < 2; ++s) Qf[e][s] = *(const bf16x8*)(qkv + (size_t)(row_tok + qc) * 3072 + hd * 32 + 16 * s + 8 * h);
#pragma unroll
            for (int i = 0; i < 16; ++i) O[e][i] = 0.f;
            mrun[e] = -1e30f; lrun[e] = 0.f; }
        u32x4 pf[10];
        const char* gb = (const char*)qkv; const unsigned goff = ((unsigned)(s0 + kcb0) * 3072u + 1024u + (unsigned)hh * 512u + (unsigned)(c.tid & 63) * 8u) * 2u;
#define NA_ISSUE(KROW) _Pragma("unroll") for (int k = 0; k < 10; ++k) { const int seg = (c.tid >> 6) + 8 * k, kv = seg >= 40 ? 1 : 0, ci = seg - 40 * kv; \
            pf[k] = *(const u32x4*)(gb + (goff + (unsigned)((KROW) * 64 + ci) * 6144u + (unsigned)kv * 2048u)); }
        NA_ISSUE(rs);
        for (int kr = 0; kr < 8; ++kr) {
            const int krow = rs + kr, dr = krow - r + 7;
            __syncthreads();
#pragma unroll
            for (int k = 0; k < 10; ++k) { const int seg = (c.tid >> 6) + 8 * k;
                if (seg < 40) *(LAS u32x4*)(KV + seg * 1024 + (c.tid & 63) * 16) = pf[k];
                else { const int ci = seg - 40, chunk = c.tid & 63; LAS bf16_t* vp = VT + (chunk >> 2) * VH + ((chunk & 3) * 8) * VP + ci; const unsigned wv[4] = {pf[k].x, pf[k].y, pf[k].z, pf[k].w};
#pragma unroll
                    for (int j2 = 0; j2 < 4; ++j2) { vp[(2 * j2) * VP] = (bf16_t)(wv[j2] & 0xffffu); vp[(2 * j2 + 1) * VP] = (bf16_t)(wv[j2] >> 16); } } }
            if (kr < 7) { NA_ISSUE(krow + 1); }
            __syncthreads();
#pragma unroll
            for (int e = 0; e < 2; ++e) {
                const int hl = 2 * c.wave + e; const LAS float* bp = rp + (hl * 15 + dr) * 31;
                f32x16 S0, S1;
#pragma unroll
                for (int i = 0; i < 16; ++i) { S0[i] = 0.f; S1[i] = 0.f; }
#pragma unroll
                for (int s = 0; s < 2; ++s) {
                    const bf16x8 A0 = *(const LAS bf16x8*)(KV + ql * 1024 + hl * 64 + (16 * s + 8 * h) * 2), A1 = *(const LAS bf16x8*)(KV + (8 + ql) * 1024 + hl * 64 + (16 * s + 8 * h) * 2);
                    S0 = __builtin_amdgcn_mfma_f32_32x32x16_bf16(A0, Qf[e][s], S0, 0, 0, 0); S1 = __builtin_amdgcn_mfma_f32_32x32x16_bf16(A1, Qf[e][s], S1, 0, 0, 0); }
                const float sc = 0.17677669529663687f * 1.44269504089f;
                float mloc = -1e30f;
#pragma unroll
                for (int i = 0; i < 16; ++i) { const int ci = (i & 3) + 8 * (i >> 2) + 4 * h;
                    { const int kcol = kcb0 + ci; const bool ok = kcol >= qsl && kcol < qsl + 16; const int dc = ok ? kcol - qc + 15 : 0; const float v = ok ? S0[i] * sc + bp[dc] : -1e30f; S0[i] = v; mloc = fmaxf(mloc, v); }
                    if (i >= 12) {
                      const int kcol = kcb0 + 8 + ci; const bool ok = kcol >= qsl && kcol < qsl + 16; const int dc = ok ? kcol - qc + 15 : 0; const float v = ok ? S1[i] * sc + bp[dc] : -1e30f; S1[i] = v; mloc = fmaxf(mloc, v); } }
                mloc = fmaxf(mloc, __shfl_xor(mloc, 32));
                const float mn = fmaxf(mrun[e], mloc), corr = __builtin_amdgcn_exp2f(mrun[e] - mn); mrun[e] = mn;
                float lsum = 0.f;
#pragma unroll
                for (int i = 0; i < 16; ++i) { O[e][i] *= corr; S0[i] = __builtin_amdgcn_exp2f(S0[i] - mn); lsum += S0[i];
                    if (i >= 12) { S1[i] = __builtin_amdgcn_exp2f(S1[i] - mn); lsum += S1[i]; } else S1[i] = 0.f; }
                lrun[e] = lrun[e] * corr + lsum;
                const LAS bf16_t* vb = VT + hl * VH + ql * VP + 4 * h;
#pragma unroll
                for (int kt = 0; kt < 2; ++kt)
#pragma unroll
                    for (int s = kt; s < 2; ++s) {
                        u32x4 pw;
                        if (kt == 0) { pw.x = cvt_pk_bf16(S0[8 * s], S0[8 * s + 1]); pw.y = cvt_pk_bf16(S0[8 * s + 2], S0[8 * s + 3]); pw.z = cvt_pk_bf16(S0[8 * s + 4], S0[8 * s + 5]); pw.w = cvt_pk_bf16(S0[8 * s + 6], S0[8 * s + 7]); }
                        else { pw.x = cvt_pk_bf16(S1[8 * s], S1[8 * s + 1]); pw.y = cvt_pk_bf16(S1[8 * s + 2], S1[8 * s + 3]); pw.z = cvt_pk_bf16(S1[8 * s + 4], S1[8 * s + 5]); pw.w = cvt_pk_bf16(S1[8 * s + 6], S1[8 * s + 7]); }
                        const u32x2 va = *(const LAS u32x2*)(vb + kt * 8 + 16 * s), vc = *(const LAS u32x2*)(vb + kt * 8 + 16 * s + 8);
                        const u32x4 vq = (u32x4){va.x, va.y, vc.x, vc.y};
                        O[e] = __builtin_amdgcn_mfma_f32_32x32x16_bf16(__builtin_bit_cast(bf16x8, vq), __builtin_bit_cast(bf16x8, pw), O[e], 0, 0, 0);
                    }
            }
        }
#undef NA_ISSUE
#pragma unroll
        for (int e = 0; e < 2; ++e) { const int hd = hh * 16 + 2 * c.wave + e; const float lt = lrun[e] + __shfl_xor(lrun[e], 32), inv = 1.0f / lt;
            bf16_t* op = o + (size_t)(row_tok + qc) * D + hd * 32 + 4 * h;
#pragma unroll
            for (int g = 0; g < 4; ++g) { u32x2 w; w.x = cvt_pk_bf16(O[e][4 * g] * inv, O[e][4 * g + 1] * inv); w.y = cvt_pk_bf16(O[e][4 * g + 2] * inv, O[e][4 * g + 3] * inv); *(u32x2*)(op + 8 * g) = w; } }
    }
    __syncthreads();
}

__device__ __forceinline__ float gelu_tanh(float g) { return 0.5f * g * (1.0f + fast_tanh(0.7978845608028654f * (g + 0.044715f * g * g * g))); }
__device__ __forceinline__ void lru_elem(const Ctx& c, const bf16_t* u, const float* cw, const float* cb, bf16_t* xb, bf16_t* gb) {
    const int ch = (c.tid & 127) * 8, rsub = c.tid >> 7;
    float wgt[4][8], bia[8];
#pragma unroll
    for (int h2 = 0; h2 < 2; ++h2) { const f32x4 b4 = *(const f32x4*)(cb + ch + 4 * h2);
#pragma unroll
        for (int e = 0; e < 4; ++e) bia[4 * h2 + e] = b4[e];
#pragma unroll
        for (int tap = 0; tap < 4; ++tap) { const f32x4 w4 = *(const f32x4*)(cw + tap * D + ch + 4 * h2);
#pragma unroll
            for (int e = 0; e < 4; ++e) wgt[tap][4 * h2 + e] = w4[e]; } }
    for (int slab = c.bid; slab < T / 192; slab += c.nblk) {
        for (int k = 0; k < 48; ++k) {
            const int row = slab * 192 + rsub + 4 * k; int s0, L; seq_of(row, s0, L); const int t = row - s0;
            const bf16_t* p = u + (size_t)row * 2048 + ch;
            const u32x4 gw_ = *(const u32x4*)p; const unsigned gv[4] = {gw_.x, gw_.y, gw_.z, gw_.w};
            u32x4 w;
            w.x = cvt_pk_bf16(gelu_tanh(bflo(gv[0])), gelu_tanh(bfhi(gv[0]))); w.y = cvt_pk_bf16(gelu_tanh(bflo(gv[1])), gelu_tanh(bfhi(gv[1])));
            w.z = cvt_pk_bf16(gelu_tanh(bflo(gv[2])), gelu_tanh(bfhi(gv[2]))); w.w = cvt_pk_bf16(gelu_tanh(bflo(gv[3])), gelu_tanh(bfhi(gv[3])));
            *(u32x4*)(gb + (size_t)row * D + ch) = w;
            float a[8];
#pragma unroll
            for (int e = 0; e < 8; ++e) a[e] = bia[e];
#pragma unroll
            for (int j = 0; j < 4; ++j) { const int tt = t + j - 2; u32x4 xw = (u32x4){0u, 0u, 0u, 0u}; if (tt >= 0 && tt < L) xw = *(const u32x4*)(p + 1024 + (ptrdiff_t)(j - 2) * 2048);
                const unsigned xv[4] = {xw.x, xw.y, xw.z, xw.w};
#pragma unroll
                for (int e = 0; e < 4; ++e) { a[2 * e] += wgt[j][2 * e] * bflo(xv[e]); a[2 * e + 1] += wgt[j][2 * e + 1] * bfhi(xv[e]); } }
            w.x = cvt_pk_bf16(a[0], a[1]); w.y = cvt_pk_bf16(a[2], a[3]); w.z = cvt_pk_bf16(a[4], a[5]); w.w = cvt_pk_bf16(a[6], a[7]);
            *(u32x4*)(xb + (size_t)row * D + ch) = w;
        }
    }
}
constexpr int CL = 64, NCH = T / CL;
#define UNPK8(W_, f) const float f[8] = {bflo((W_).x), bfhi((W_).x), bflo((W_).y), bfhi((W_).y), bflo((W_).z), bfhi((W_).z), bflo((W_).w), bfhi((W_).w)}
__device__ __forceinline__ void lru_scan1(const Ctx& c, const bf16_t* la0, const bf16_t* bb0, const bf16_t* la1, const bf16_t* bb1, f32x2* agg) {
    const int n = NCH * (D / 8);
    for (int i = c.bid * NTHR + c.tid; i < n; i += c.nblk * NTHR) {
        const int ck = i / (D / 8), ch = (i % (D / 8)) * 8; const size_t base = (size_t)ck * CL * D + ch;
        float sl0[8], hb0[8], sl1[8], hb1[8];
#pragma unroll
        for (int e = 0; e < 8; ++e) { sl0[e] = 0.f; hb0[e] = 0.f; sl1[e] = 0.f; hb1[e] = 0.f; }
#pragma unroll 4
        for (int tt = 0; tt < CL; ++tt) { const size_t of = base + (size_t)tt * D, ob = base + (size_t)(CL - 1 - tt) * D;
            const u32x4 lw = *(const u32x4*)(la0 + of), bw = *(const u32x4*)(bb0 + of), lw1 = *(const u32x4*)(la1 + ob), bw1 = *(const u32x4*)(bb1 + ob);
            UNPK8(lw, lf); UNPK8(bw, bf_); UNPK8(lw1, lg); UNPK8(bw1, bg);
#pragma unroll
            for (int e = 0; e < 8; ++e) { hb0[e] = fast_exp(lf[e]) * hb0[e] + bf_[e]; sl0[e] += lf[e]; hb1[e] = fast_exp(lg[e]) * hb1[e] + bg[e]; sl1[e] += lg[e]; } }
        f32x2* ap = agg + (size_t)(ck * 2 + 0) * D + ch; f32x2* aq = agg + (size_t)(ck * 2 + 1) * D + ch;
#pragma unroll
        for (int e = 0; e < 8; e += 2) { *(f32x4*)(ap + e) = (f32x4){fast_exp(sl0[e]), hb0[e], fast_exp(sl0[e + 1]), hb0[e + 1]}; *(f32x4*)(aq + e) = (f32x4){fast_exp(sl1[e]), hb1[e], fast_exp(sl1[e + 1]), hb1[e + 1]}; }
    }
}
__device__ __forceinline__ void lru_carry(const Ctx& c, const f32x2* agg, float* car) {
    const int n = 5 * 2 * D;
    for (int i = c.bid * NTHR + c.tid; i < n; i += c.nblk * NTHR) {
        const int ch = i % D, dir = (i / D) & 1, sq = i / (2 * D);
        const int ck0 = sq == 0 ? 0 : (TP + (sq - 1) * LS) / CL, nck = sq == 0 ? TP / CL : LS / CL;
        float h = 0.f;
        for (int k0 = 0; k0 < nck; k0 += 16) {
            f32x2 ab[16];
#pragma unroll
            for (int k = 0; k < 16; ++k) { const int kk = dir ? nck - 1 - (k0 + k) : k0 + k; ab[k] = agg[(size_t)((ck0 + kk) * 2 + dir) * D + ch]; }
#pragma unroll
            for (int k = 0; k < 16; ++k) { const int kk = dir ? nck - 1 - (k0 + k) : k0 + k; car[(size_t)((ck0 + kk) * 2 + dir) * D + ch] = h; h = ab[k].x * h + ab[k].y; }
        }
    }
}
__device__ __forceinline__ void lru_scan2(const Ctx& c, const bf16_t* la0, const bf16_t* bb0, const bf16_t* la1, bf16_t* bb1, const float* car, bf16_t* gb) {
    const int n = NCH * (D / 8);
    for (int i = c.bid * NTHR + c.tid; i < n; i += c.nblk * NTHR) {
        const int ck = i / (D / 8), ch = (i % (D / 8)) * 8; const size_t base = (size_t)ck * CL * D + ch;
        float h[8];
        { const f32x4 c0 = *(const f32x4*)(car + (size_t)(ck * 2 + 1) * D + ch), c1 = *(const f32x4*)(car + (size_t)(ck * 2 + 1) * D + ch + 4);
          h[0] = c0[0]; h[1] = c0[1]; h[2] = c0[2]; h[3] = c0[3]; h[4] = c1[0]; h[5] = c1[1]; h[6] = c1[2]; h[7] = c1[3]; }
#pragma unroll 4
        for (int t = CL - 1; t >= 0; --t) { const size_t o = base + (size_t)t * D; const u32x4 lw = *(const u32x4*)(la1 + o), bw = *(const u32x4*)(bb1 + o);
            UNPK8(lw, lf); UNPK8(bw, bf_);
#pragma unroll
            for (int e = 0; e < 8; ++e) h[e] = fast_exp(lf[e]) * h[e] + bf_[e];
            u32x4 w; w.x = cvt_pk_bf16(h[0], h[1]); w.y = cvt_pk_bf16(h[2], h[3]); w.z = cvt_pk_bf16(h[4], h[5]); w.w = cvt_pk_bf16(h[6], h[7]); *(u32x4*)(bb1 + o) = w; }
        { const f32x4 c0 = *(const f32x4*)(car + (size_t)(ck * 2 + 0) * D + ch), c1 = *(const f32x4*)(car + (size_t)(ck * 2 + 0) * D + ch + 4);
          h[0] = c0[0]; h[1] = c0[1]; h[2] = c0[2]; h[3] = c0[3]; h[4] = c1[0]; h[5] = c1[1]; h[6] = c1[2]; h[7] = c1[3]; }
#pragma unroll 4
        for (int t = 0; t < CL; ++t) { const size_t o = base + (size_t)t * D; const u32x4 lw = *(const u32x4*)(la0 + o), bw = *(const u32x4*)(bb0 + o), rw = *(const u32x4*)(bb1 + o), gw_ = *(const u32x4*)(gb + o);
            UNPK8(lw, lf); UNPK8(bw, bf_); UNPK8(rw, rf); UNPK8(gw_, gf);
#pragma unroll
            for (int e = 0; e < 8; ++e) h[e] = fast_exp(lf[e]) * h[e] + bf_[e];
            u32x4 w; w.x = cvt_pk_bf16(gf[0] * (h[0] + rf[0]), gf[1] * (h[1] + rf[1])); w.y = cvt_pk_bf16(gf[2] * (h[2] + rf[2]), gf[3] * (h[3] + rf[3]));
            w.z = cvt_pk_bf16(gf[4] * (h[4] + rf[4]), gf[5] * (h[5] + rf[5])); w.w = cvt_pk_bf16(gf[6] * (h[6] + rf[6]), gf[7] * (h[7] + rf[7])); *(u32x4*)(gb + o) = w; }
    }
}
#undef UNPK8
__device__ __forceinline__ void final_norm(const Ctx& c, const bf16_t* hbf, float* out, const float* rss, const float* g) {
    const size_t n4 = (size_t)T * D / 4;
    for (size_t i = (size_t)c.bid * NTHR + c.tid; i < n4; i += (size_t)c.nblk * NTHR) {
        const int row = (int)(i / (D / 4)), c4 = (int)(i % (D / 4)) * 4; const float rs = pg8::rstd_of(rss, row);
        const u32x2 w = *(const u32x2*)(hbf + i * 4); const f32x4 gv = *(const f32x4*)(g + c4);
        f32x4 v = (f32x4){bflo(w.x), bfhi(w.x), bflo(w.y), bfhi(w.y)}; v = v * rs * gv; *(f32x4*)(out + i * 4) = v;
    }
}

__device__ __forceinline__ const float* ldptr(volatile LAS unsigned* tab, int k) {
    unsigned lo = tab[2 * k], hi = tab[2 * k + 1]; lo = __builtin_amdgcn_readfirstlane(lo); hi = __builtin_amdgcn_readfirstlane(hi);
    return (const float*)(const __attribute__((address_space(1))) float*)(((unsigned long long)hi << 32) | (unsigned long long)lo);
}
#define IN(k) ldptr(tab, (k))
#define WGU1 ((bf16_t*)(ws + WS_WGU1))
#define WD1 ((bf16_t*)(ws + WS_WD1))
#define WGU2 ((bf16_t*)(ws + WS_WGU2))
#define WD2 ((bf16_t*)(ws + WS_WD2))
#define WPG ((bf16_t*)(ws + WS_WPG))
#define WPP ((bf16_t*)(ws + WS_WPP))
#define WMI ((bf16_t*)(ws + WS_WMI))
#define WMO ((bf16_t*)(ws + WS_WMO))
#define WLG ((bf16_t*)(ws + WS_WLG))
#define LSP ((float*)(ws + WS_SMALL))
#define RSS ((float*)(ws + WS_RSS2))
#define AGG ((f32x2*)(ws + WS_AGG))
#define S1 ((bf16_t*)(ws + WS_S1))
#define M1 ((bf16_t*)(ws + WS_M1))
#define M2 ((bf16_t*)(ws + WS_M2))
#define M3 ((bf16_t*)(ws + WS_M3))
#define PBF ((bf16_t*)out + (size_t)T * D)
#define RS ((bf16_t*)out)
#define RSSI(k) (RSS + (size_t)((k) & 1) * T * 16)
#define EPSET(k, v) do { const unsigned long long v_ = (unsigned long long)(v); eptab[2 * (k)] = (unsigned)v_; eptab[2 * (k) + 1] = (unsigned)(v_ >> 32); } while (0)
#define EPBEGIN __syncthreads(); if (c.tid == 0) {
#define EPEND } __syncthreads();
#define GEMM(EpiT, Aptr, Bptr, N_, K_, lda_, ldb_, agrp_) pg8::gemm_phase<EpiT, K_, lda_, ldb_, N_, agrp_>(c.lds, Aptr, Bptr, G, bid, c.tid)

constexpr int NSTEP = 14;
__device__ __forceinline__ void table_init(const Params& P, unsigned char* lds_raw) {
    volatile LAS unsigned* tab0 = (volatile LAS unsigned*)((LAS unsigned char*)lds_raw + TAB_OFF);
    if (threadIdx.x == 0) {
#pragma unroll
        for (int k = 0; k < 48; ++k) { const unsigned long long v = (unsigned long long)P.in[k]; tab0[2 * k] = (unsigned)v; tab0[2 * k + 1] = (unsigned)(v >> 32); }
        { const unsigned long long v = (unsigned long long)P.out; tab0[96] = (unsigned)v; tab0[97] = (unsigned)(v >> 32); }
        { const unsigned long long v = (unsigned long long)P.ws; tab0[98] = (unsigned)v; tab0[99] = (unsigned)(v >> 32); }
    }
    __syncthreads();
}
template <int STEP>
__device__ __forceinline__ void run_step(int step_rt, int layer, unsigned char* lds_raw, bool& did, bool& sync) {
    {
        const int step = STEP >= 0 ? STEP : step_rt, kind = layer % 3, j = layer / 3;
        int tid_ = threadIdx.x, bid = blockIdx.x, G = gridDim.x; LAS unsigned char* lds_ = (LAS unsigned char*)lds_raw;
        asm volatile("" : "+v"(tid_)); asm volatile("" : "+s"(bid)); asm volatile("" : "+s"(G)); asm volatile("" : "+s"(lds_));
        Ctx c; c.tid = tid_; c.lane = c.tid & 63; c.wave = __builtin_amdgcn_readfirstlane(c.tid >> 6); c.bid = bid; c.nblk = G; c.lds = lds_;
        volatile LAS unsigned* tab = (volatile LAS unsigned*)(c.lds + TAB_OFF);
        volatile LAS unsigned* eptab = (volatile LAS unsigned*)(c.lds + TAB_OFF + 1024);
        unsigned char* ws = (unsigned char*)ldptr(tab, 49); float* out = (float*)ldptr(tab, 48);
        bool did = true, sync = true;
        switch (step) {
        case 0: {
            const size_t fo = (size_t)layer * D * DFF;
            convT(c, IN(5) + fo, D, DFF, DFF, IN(4) + layer * D, WGU1, D, 128, 256, 0);
            convT(c, IN(6) + fo, D, DFF, DFF, IN(4) + layer * D, WGU1, D, 128, 256, 128);
            convT(c, IN(7) + fo, DFF, D, D, nullptr, WD1, DFF, D, 0, 0);
            convT(c, IN(10) + fo, D, DFF, DFF, IN(9) + layer * D, WGU2, D, 128, 256, 0);
            convT(c, IN(11) + fo, D, DFF, DFF, IN(9) + layer * D, WGU2, D, 128, 256, 128);
            convT(c, IN(12) + fo, DFF, D, D, nullptr, WD2, DFF, D, 0, 0);
            convT(c, IN(14) + (size_t)layer * D * D, D, D, D, IN(13) + layer * D, WPG, D, D, 0, 0);
            convT(c, IN(15) + (size_t)layer * PLE * D, PLE, D, D, nullptr, WPP, PLE, D, 0, 0);
            const float* lnm = IN(8) + layer * D;
            const float* wi = kind == 0 ? IN(17) + (size_t)j * D * 3 * D : (kind == 1 ? IN(32) : IN(37));
            const float* wo = kind == 0 ? IN(30) + (size_t)j * D * D : (kind == 1 ? IN(35) : IN(46));
            const int ni = kind == 2 ? 2 * D : 3 * D;
            convT(c, wi, D, ni, ni, lnm, WMI, D, ni, 0, 0);
            convT(c, wo, D, D, D, nullptr, WMO, D, D, 0, 0);
            if (kind == 0) { const float* wo_ = IN(28) + (size_t)j * 64 * 2048; for (int i = bid * NTHR + c.tid; i < 64 * 2048; i += G * NTHR) ((bf16_t*)LSP)[i] = f2bf(wo_[(i & 63) * 2048 + (i >> 6)]); }
            if (kind == 2) {
                for (int dg = 0; dg < 16; ++dg)
                    convT(c, IN((dg & 1) ? 41 : 43) + (size_t)(dg >> 1) * 65536, 256, 256, 256, nullptr, WLG + (size_t)(dg >> 1) * 512 * 256, 256, 128, 256, (dg & 1) * 128);
                for (int i = bid * NTHR + c.tid; i < 2 * D; i += G * NTHR) { const float lam = IN(45)[i]; LSP[i] = -8.0f * 0.69314718056f * __builtin_amdgcn_logf(1.0f + fast_exp(-lam)); } }
            if (layer == 0) x_to_bf16(c, IN(0), IN(1), M2, RSSI(0));
        } break;
        case 1: case 10: {
            EPBEGIN EPSET(0, S1); EPSET(1, RSSI(4 * layer + (step == 1 ? 0 : 2))); EPEND
            GEMM(pg8::EpiSwiGLU, (step == 1 ? M2 : RS), (step == 1 ? WGU1 : WGU2), 2 * DFF, D, D, D, false);
            if (step == 1) {
                const int rem = (T / 256) * (2 * DFF / 256) % G;
                if (rem == 0 || bid >= rem) { Ctx c2 = c; c2.bid = rem == 0 ? bid : bid - rem; c2.nblk = rem == 0 ? G : G - rem;
                    p_to_bf16(c2, IN(2) + (size_t)layer * TP * PLE, IN(3) + (size_t)layer * TS * PLE, PBF); } }
        } break;
        case 2: case 9: case 11: {
            const float* mb = step != 9 ? nullptr : (kind == 0 ? IN(31) + j * D : (kind == 1 ? IN(36) : IN(47)));
            const float scale = step == 9 ? 1.0f : 0.5f;
            EPBEGIN EPSET(1, 0); EPSET(2, mb); EPSET(3, (step == 2 ? M2 : RS)); EPSET(5, RS); EPSET(6, RSSI(4 * layer + (step == 2 ? 1 : (step == 9 ? 2 : 3)))); EPSET(7, 0); EPSET(8, __float_as_uint(scale)); EPEND
            if (step == 9) { const bf16_t* A = kind == 0 ? S1 : (kind == 1 ? M1 : M2); GEMM(pg8::EpiResid<0>, A, WMO, D, D, D, D, false); }
            else GEMM(pg8::EpiResid<0>, S1, (step == 2 ? WD1 : WD2), D, DFF, DFF, DFF, false);
            sync = step != 11;
        } break;
        case 3: {
            const float* bias = kind == 0 ? IN(18) + (size_t)j * 3 * D : (kind == 1 ? IN(33) : IN(38));
            EPBEGIN EPSET(0, S1); EPSET(1, RSSI(4 * layer + 1)); EPSET(2, bias); EPSET(3, kind == 2 ? 2 * D : 3 * D); EPEND
            if (kind == 2) GEMM(pg8::EpiProj, RS, WMI, 2 * D, D, D, D, false); else GEMM(pg8::EpiProj, RS, WMI, 3 * D, D, D, D, false);
        } break;
        case 12: {
            EPBEGIN EPSET(0, M1); EPSET(1, 0); EPSET(2, 0); EPSET(3, D); EPEND
            GEMM(pg8::EpiProj, PBF, WPP, D, PLE, PLE, PLE, false);
        } break;
        case 4: {
            if (kind == 0) hy_elem(c, S1, IN(19) + (size_t)j * 9 * D, IN(20) + (size_t)j * 3 * D, M1, M2, M3);
            else if (kind == 1) na_attn(c, S1, IN(34), M1);
            else lru_elem(c, S1, IN(39), IN(40), M1, M2);
        } break;
        case 5: {
            if (kind == 0) {
                bf16_t* FK = S1 + (size_t)T * D;
                for (int hl = 0; hl < 2; ++hl)
                    hy_filter(c, hl ? LS : TP, hl ? (size_t)D * 2 * TP : (size_t)0, IN(21) + j * 33 * 64, IN(22) + j * 64, IN(23) + j * 4096, IN(24) + j * 64, IN(25) + j * 4096, IN(26) + j * 64, IN(27) + j * 64, (const bf16_t*)LSP, IN(29) + j * D, FK);
            } else if (kind == 2) {
                EPBEGIN EPSET(0, M1); EPSET(1, S1); EPSET(2, S1 + 2 * (size_t)T * D); EPSET(3, S1 + (size_t)T * D); EPSET(4, M3); EPSET(5, IN(44)); EPSET(6, IN(42)); EPSET(7, LSP); EPEND
                GEMM(pg8::EpiLruGates, M1, WLG, 4096, 256, D, 256, true);
            } else did = false;
        } break;
        case 6: {
            if (kind == 0) hy_longconv(c, M3, S1 + (size_t)T * D, S1 + 2 * (size_t)T * D);
            else if (kind == 2) lru_scan1(c, S1, S1 + (size_t)T * D, S1 + 2 * (size_t)T * D, M3, AGG);
            else did = false;
        } break;
        case 7: { if (kind == 2) lru_carry(c, AGG, (float*)(ws + WS_CAR)); else if (kind == 0) hy_final(c, S1 + 2 * (size_t)T * D, M1, M2, IN(29) + j * D, S1); else did = false; } break;
        case 8: { if (kind == 2) lru_scan2(c, S1, S1 + (size_t)T * D, S1 + 2 * (size_t)T * D, M3, (const float*)(ws + WS_CAR), M2); else did = false; } break;
        default: {
            EPBEGIN EPSET(1, RSSI(4 * layer + 3)); EPSET(2, 0); EPSET(3, RS); EPSET(5, M2); EPSET(6, RSSI(4 * layer + 4)); EPSET(7, M1); EPSET(8, 0); EPEND
            GEMM(pg8::EpiResid<1>, RS, WPG, D, D, D, D, false);
        } break;
        }
    }
}
template <int STEP>
__global__ void __launch_bounds__(NTHR, 2) step_kernel(Params P, int layer) {
    extern __shared__ __attribute__((aligned(16))) unsigned char lds_raw[];
    table_init(P, lds_raw);
    bool did = true, sync = true;
    run_step<STEP>(STEP, layer, lds_raw, did, sync);
}
__global__ void __launch_bounds__(NTHR, 2) final_kernel(Params P) {
    Ctx c; c.tid = threadIdx.x; c.lane = c.tid & 63; c.wave = __builtin_amdgcn_readfirstlane(c.tid >> 6); c.bid = blockIdx.x; c.nblk = gridDim.x; c.lds = nullptr;
    final_norm(c, (const bf16_t*)(P.ws + WS_M2), P.out, (const float*)(P.ws + WS_RSS2), P.in[16]);
}
__global__ void __launch_bounds__(NTHR, 2) trunk_fwd(Params P) {
    extern __shared__ __attribute__((aligned(16))) unsigned char lds_raw[];
    cg::grid_group grid = cg::this_grid();
    {   volatile LAS unsigned* st0 = (volatile LAS unsigned*)((LAS unsigned char*)lds_raw + TAB_OFF + 2048);
        if (threadIdx.x == 0) { st0[0] = 0u; st0[1] = 0u; (void)xb_add(&((unsigned*)(P.ws + WS_BAR))[XB_XCNT(xb_xcc_id())], 1u); } }
    table_init(P, lds_raw);
#pragma nounroll
    for (int ph = 0; ph < 4 * NSTEP; ++ph) {
        bool did = true, sync = true;
        run_step<-1>(ph % NSTEP, ph / NSTEP, lds_raw, did, sync);
#if PROBE
        {   const int st_ = ph % NSTEP; bool rep = false;
            if ((PROBE & 1) && (st_ == 1 || st_ == 10)) rep = true;
            if ((PROBE & 2) && st_ == 6 && (ph / NSTEP) % 3 == 0) rep = true;
            if ((PROBE & 8) && st_ == 0) rep = true;
            if ((PROBE & 16) && st_ == 3) rep = true;
            if ((PROBE & 32) && (st_ == 4 || st_ == 5) ) rep = true;
            { const int kd_ = (ph / NSTEP) % 3;
              if ((PROBE & 64) && st_ == 4 && kd_ == 0) rep = true;
              if ((PROBE & 128) && st_ == 5 && kd_ == 0) rep = true;
              if ((PROBE & 256) && st_ == 4 && kd_ == 1) rep = true;
              if ((PROBE & 512) && st_ == 4 && kd_ == 2) rep = true;
              if ((PROBE & 1024) && st_ == 5 && kd_ == 2) rep = true;
              if ((PROBE & 2048) && st_ == 6 && kd_ == 2) rep = true;
              if ((PROBE & 4096) && st_ == 7 && kd_ == 0) rep = true; }
            if (rep) { if (did && sync) xcd_barrier((unsigned*)(P.ws + WS_BAR), (volatile LAS unsigned*)((LAS unsigned char*)lds_raw + TAB_OFF + 2048)); run_step<-1>(ph % NSTEP, ph / NSTEP, lds_raw, did, sync); }
            if ((PROBE & 4) && did && sync) xcd_barrier((unsigned*)(P.ws + WS_BAR), (volatile LAS unsigned*)((LAS unsigned char*)lds_raw + TAB_OFF + 2048)); }
#endif
        if (did && sync) {
            if (ph == 0) grid.sync();
            else xcd_barrier((unsigned*)(P.ws + WS_BAR), (volatile LAS unsigned*)((LAS unsigned char*)lds_raw + TAB_OFF + 2048));
        }
    }
    {   Ctx c; c.tid = threadIdx.x; c.lane = c.tid & 63; c.wave = __builtin_amdgcn_readfirstlane(c.tid >> 6); c.bid = blockIdx.x; c.nblk = gridDim.x; c.lds = (LAS unsigned char*)lds_raw;
        final_norm(c, (const bf16_t*)(P.ws + WS_M2), P.out, (const float*)(P.ws + WS_RSS2), P.in[16]); }
}

#ifndef MEGA
#define MEGA 1
#endif
template <int STEP> static void launch_step(const Params& p, int layer, int grid, hipStream_t stream) {
    static bool attr = false;
    if (!attr) { (void)hipFuncSetAttribute((const void*)step_kernel<STEP>, hipFuncAttributeMaxDynamicSharedMemorySize, LDS_BYTES); attr = true; }
    hipLaunchKernelGGL(step_kernel<STEP>, dim3(grid), dim3(NTHR), LDS_BYTES, stream, p, layer);
}
extern "C" void kernel_launch(void* const* d_in, const int* in_sizes, int n_in, void* d_out, int out_size, void* d_ws, size_t ws_size, hipStream_t stream) {
    static int grid = 0;
    if (grid == 0) {
        if (n_in != 48 || out_size != T * D || ws_size < WS_END) { fprintf(stderr, "kernel_launch: unexpected shapes n_in %d out %d ws %zu (need %zu)\n", n_in, out_size, ws_size, (size_t)WS_END); grid = -1; return; }
        int dev = 0, cus = 0;
        (void)hipGetDevice(&dev); (void)hipDeviceGetAttribute(&cus, hipDeviceAttributeMultiprocessorCount, dev);
        if (hipFuncSetAttribute((const void*)trunk_fwd, hipFuncAttributeMaxDynamicSharedMemorySize, LDS_BYTES) != hipSuccess) { fprintf(stderr, "kernel_launch: hipFuncSetAttribute failed\n"); grid = -1; return; }
        (void)hipGetLastError();
        grid = cus;
    }
    if (grid < 0) return;
    Params p{};
    for (int i = 0; i < 48; ++i) p.in[i] = (const float*)d_in[i];
    p.out = (float*)d_out; p.ws = (unsigned char*)d_ws;
#if MEGA
    (void)hipMemsetAsync((unsigned char*)d_ws + WS_BAR, 0, XCD_BAR_WORDS * 4, stream);
    void* args[] = {&p};
    hipError_t e = hipLaunchCooperativeKernel((const void*)trunk_fwd, dim3(grid), dim3(NTHR), args, LDS_BYTES, stream);
    if (e != hipSuccess) fprintf(stderr, "cooperative launch failed: %s (grid %d)\n", hipGetErrorString(e), grid);
#else
    for (int layer = 0; layer < 4; ++layer) {
        const int kind = layer % 3;
        launch_step<0>(p, layer, grid, stream); launch_step<1>(p, layer, grid, stream); launch_step<2>(p, layer, grid, stream); launch_step<3>(p, layer, grid, stream);
        launch_step<4>(p, layer, grid, stream);
        if (kind != 1) { launch_step<5>(p, layer, grid, stream); launch_step<6>(p, layer, grid, stream); }
        if (kind != 1) launch_step<7>(p, layer, grid, stream);
        if (kind == 2) launch_step<8>(p, layer, grid, stream);
        launch_step<9>(p, layer, grid, stream); launch_step<10>(p, layer, grid, stream); launch_step<11>(p, layer, grid, stream); launch_step<12>(p, layer, grid, stream); launch_step<13>(p, layer, grid, stream);
    }
    hipLaunchKernelGGL(final_kernel, dim3(grid), dim3(NTHR), 0, stream, p);
#endif
}
```

```cpp
#include <hip/hip_runtime.h>
#include <hip/hip_cooperative_groups.h>
#include <cstdio>
namespace cg = cooperative_groups;

#define LAS __attribute__((address_space(3)))
typedef unsigned short bf16_t;
typedef short bf16x8 __attribute__((ext_vector_type(8)));
typedef float f32x4 __attribute__((ext_vector_type(4)));
typedef float f32x2 __attribute__((ext_vector_type(2)));
typedef float f32x16 __attribute__((ext_vector_type(16)));
typedef unsigned u32x4 __attribute__((ext_vector_type(4)));
typedef unsigned u32x2 __attribute__((ext_vector_type(2)));

#ifndef PROBE
#define PROBE 0
#endif
constexpr int D = 1024, DFF = 2816, TP = 16384, TS = 32768, T = TP + TS, LS = 8192, PLE = 256;
constexpr int NTHR = 512;
constexpr float EPS = 1e-6f;
constexpr size_t MiB = 1u << 20;
constexpr size_t UB = (size_t)T * D * 2;
constexpr size_t WS_WGU1 = 0, WS_WD1 = 11 * MiB, WS_WGU2 = WS_WD1 + 11 * MiB / 2, WS_WD2 = WS_WGU2 + 11 * MiB, WS_WPG = 33 * MiB, WS_WPP = 35 * MiB,
                 WS_WMI = WS_WPP + MiB / 2, WS_WMO = WS_WMI + 6 * MiB, WS_WLG = WS_WMO + 2 * MiB, WS_SMALL = WS_WLG + 2 * MiB, WS_RSS = 46 * MiB,
                 WS_AGG = 50 * MiB, WS_S1 = 62 * MiB, WS_M1 = WS_S1 + 3 * UB, WS_M2 = WS_M1 + UB, WS_M3 = WS_M2 + UB, WS_RSS2 = WS_M3 + UB, WS_BAR = WS_RSS2 + 7 * MiB, WS_CAR = WS_RSS2 + 8 * MiB, WS_END = WS_CAR + 6 * MiB;
constexpr int TAB_OFF = 143360, LDS_BYTES = 147456;

struct Params { const float* in[48]; float* out; unsigned char* ws; };

__device__ __forceinline__ unsigned cvt_pk_bf16(float lo, float hi) { unsigned r; asm volatile("v_cvt_pk_bf16_f32 %0, %1, %2" : "=v"(r) : "v"(lo), "v"(hi)); return r; }
__device__ __forceinline__ float bflo(unsigned w) { return __uint_as_float(w << 16); }
__device__ __forceinline__ float bfhi(unsigned w) { return __uint_as_float(w & 0xffff0000u); }
__device__ __forceinline__ float bf2f(bf16_t b) { return __uint_as_float(((unsigned)b) << 16); }
__device__ __forceinline__ bf16_t f2bf(float f) { return (bf16_t)(cvt_pk_bf16(f, 0.f) & 0xffffu); }
__device__ __forceinline__ float fast_sigmoid(float x) { return __builtin_amdgcn_rcpf(1.0f + __builtin_amdgcn_exp2f(-1.44269504089f * x)); }
__device__ __forceinline__ float fast_exp(float x) { return __builtin_amdgcn_exp2f(1.44269504089f * x); }
__device__ __forceinline__ float hw_sin(float x) { return __builtin_amdgcn_sinf(x * 0.15915494309189535f); }
__device__ __forceinline__ float hw_cos(float x) { return __builtin_amdgcn_cosf(x * 0.15915494309189535f); }
__device__ __forceinline__ float fast_tanh(float y) { return 1.0f - 2.0f * __builtin_amdgcn_rcpf(1.0f + __builtin_amdgcn_exp2f(2.88539008178f * y)); }

namespace pg8 {
constexpr int BM = 256, BK = 64, HALF = 128, HTB = HALF * BK * 2, STAGE_BYTES = 8 * HTB, NXCD = 8, WGM = 8;
__host__ __device__ __forceinline__ int lds_byte(int r, int c) { const int st = (r >> 4) * 2 + (c >> 5), rr = r & 15, cc = c & 31, ob = rr * 64 + cc * 2; return st * 1024 + (ob ^ (((ob >> 9) & 1) << 5)); }
__host__ __device__ __forceinline__ void stage_rc(int b, int& R, int& C) { const int st = b / 1024, sb = b % 1024, swz = sb ^ (((sb >> 9) & 1) << 5); R = (st >> 1) * 16 + swz / 64; C = (st & 1) * 32 + (swz % 64) / 2; }
__host__ __device__ __forceinline__ int perm32(int rho) { const int n = rho >> 4, i = rho & 15; return 8 * (i >> 2) + 4 * n + (i & 3); }

struct Unit { int pm, pn; };
struct Gemm { const bf16_t* A; const bf16_t* Bt; int M, N, K, lda, ldb, agrp; };

struct StaticOrder {
    int nM, nN, nwg, G, c, rev;
    __host__ __device__ void init(int M, int N, int G_, int c_) { nM = M / BM; nN = N / BM; nwg = nM * nN; G = G_; c = c_; rev = 0; }
    __host__ __device__ bool next(int i, Unit& u) const {
        const int L = i * G + c; if (L >= nwg) return false;
        int wgid = L; { const int q = nwg / NXCD, r = nwg % NXCD, xcd = wgid % NXCD, off = wgid / NXCD; wgid = (xcd < r ? xcd * (q + 1) : r * (q + 1) + (xcd - r) * q) + off; }
        const int nig = WGM * nN, gid = wgid / nig, fm = gid * WGM, gsz = (nM - fm) < WGM ? (nM - fm) : WGM;
        u.pm = fm + ((wgid % nig) % gsz); u.pn = (wgid % nig) / gsz; if (rev) u.pm = nM - 1 - u.pm; return true;
    }
};

template <class Epi, int KK, int LDA, int LDB, int NN, bool AGRP>
__device__ __forceinline__ void gemm_phase(LAS unsigned char* lds, const bf16_t* gA, const bf16_t* gBt, int G_, int bid_, int tid, int rev_) {
    const Epi E{};
    struct { const bf16_t* A; const bf16_t* Bt; int lda, ldb, agrp; } g{gA, gBt, LDA, LDB, AGRP ? 1 : 0};
    StaticOrder S; S.init(49152, NN, G_, bid_); S.rev = rev_;
    const int wid = __builtin_amdgcn_readfirstlane(tid >> 6), lane = tid & 63, wr = wid >> 2, wc = wid & 3, fr = lane & 15, fq = lane >> 4;
    constexpr int K = KK, nt = K / BK;
    unsigned voffA[2], voffB[2];
#pragma unroll
    for (int i = 0; i < 2; ++i) { int R, C; stage_rc(tid * 16 + i * 8192, R, C); const int Rb = Epi::PERM ? ((R & ~31) + perm32(R & 31)) : R;
        voffA[i] = (unsigned)(R * g.lda + C) * 2u; voffB[i] = (unsigned)(Rb * g.ldb + C) * 2u; }
    const size_t kstep = (size_t)(BK * 2);
    constexpr size_t hstepA = (size_t)HALF * LDA * 2, hstepB = (size_t)HALF * LDB * 2;
    constexpr size_t tstepA = 2 * hstepA, tstepB = 2 * hstepB;
    const unsigned ldsw = (unsigned)wid * 1024u;
    const int aoff = lds_byte(wr * 64 + fr, fq * 8), boff = lds_byte(wc * 32 + fr, fq * 8);
#define PG8_SA(b, h) (((b) * 2 + (h)) * HTB)
#define PG8_SB(b, h) ((4 + (b) * 2 + (h)) * HTB)
#define PG8_STAGE(bufoff, gbase, voff) do { _Pragma("unroll") for (int _i = 0; _i < 2; ++_i) \
        __builtin_amdgcn_global_load_lds((const unsigned*)((const char*)(gbase) + (voff)[_i]), (LAS unsigned*)(lds + (bufoff) + ldsw + _i * 8192), 16, 0, 0); } while (0)
#define PG8_LDA(dst, b, h) do { _Pragma("unroll") for (int m = 0; m < 4; ++m) _Pragma("unroll") for (int k = 0; k < 2; ++k) dst[m][k] = *(const LAS bf16x8*)(lds + PG8_SA(b, h) + aoff + m * 2048 + k * 1024); } while (0)
#define PG8_LDB(dst, b, h) do { _Pragma("unroll") for (int n = 0; n < 2; ++n) _Pragma("unroll") for (int k = 0; k < 2; ++k) dst[n][k] = *(const LAS bf16x8*)(lds + PG8_SB(b, h) + boff + n * 2048 + k * 1024); } while (0)
#define PG8_MMA(ai, bj, At, Bt) do { __builtin_amdgcn_s_setprio(1); _Pragma("unroll") for (int m = 0; m < 4; ++m) _Pragma("unroll") for (int n = 0; n < 2; ++n) _Pragma("unroll") for (int k = 0; k < 2; ++k) \
        acc[ai][bj][m][n] = __builtin_amdgcn_mfma_f32_16x16x32_bf16(Bt[n][k], At[m][k], acc[ai][bj][m][n], 0, 0, 0); __builtin_amdgcn_s_setprio(0); } while (0)
#define PG8_WAIT_V(n) asm volatile("s_waitcnt vmcnt(" #n ")" ::: "memory")
#define PG8_WAIT_L(n) asm volatile("s_waitcnt lgkmcnt(" #n ")" ::: "memory")
#define PG8_BAR __builtin_amdgcn_s_barrier()
#define PG8_SCHED __builtin_amdgcn_sched_barrier(0)
#define PG8_ACOL(pn) (AGRP ? (size_t)((((pn) >> 1) & 3) * 512) : (size_t)0)
    Unit cur, nxt; int ui = 0;
    if (!S.next(0, cur)) return;
    float zr = 0.f; asm volatile("" : "+v"(zr));
    f32x4 acc[2][2][4][2];
#pragma unroll
    for (int a = 0; a < 2; ++a)
#pragma unroll
        for (int b = 0; b < 2; ++b)
#pragma unroll
            for (int m = 0; m < 4; ++m)
#pragma unroll
                for (int n = 0; n < 2; ++n) acc[a][b][m][n] = (f32x4){zr, zr, zr, zr};
    bf16x8 At[4][2], B0[2][2], B1[2][2];
    const char* cA = (const char*)g.A + (size_t)cur.pm * tstepA + PG8_ACOL(cur.pn); const char* cB = (const char*)g.Bt + (size_t)cur.pn * tstepB;
    PG8_STAGE(PG8_SB(0, 0), cB, voffB); PG8_STAGE(PG8_SA(0, 0), cA, voffA); PG8_STAGE(PG8_SB(0, 1), cB + hstepB, voffB); PG8_STAGE(PG8_SA(0, 1), cA + hstepA, voffA);
    if (wr == 1) PG8_BAR;
    PG8_WAIT_V(4); PG8_BAR;
    PG8_STAGE(PG8_SB(1, 0), cB + kstep, voffB); PG8_STAGE(PG8_SA(1, 0), cA + kstep, voffA); PG8_STAGE(PG8_SB(1, 1), cB + hstepB + kstep, voffB);
    PG8_WAIT_V(6); PG8_BAR;
    for (;;) {
        const bool has_next = S.next(ui + 1, nxt);
        const char* nA = has_next ? (const char*)g.A + (size_t)nxt.pm * tstepA + PG8_ACOL(nxt.pn) : cA; const char* nB = has_next ? (const char*)g.Bt + (size_t)nxt.pn * tstepB : cB;
#pragma nounroll
        for (int t = 0; t < nt; t += 2) {
            const bool last = (t == nt - 2);
            const char* a1 = cA + (size_t)(t + 1) * kstep;
            const char* a2 = last ? nA : cA + (size_t)(t + 2) * kstep; const char* b2 = last ? nB : cB + (size_t)(t + 2) * kstep;
            const char* a3 = a2 + kstep; const char* b3 = b2 + kstep;
            PG8_LDB(B0, 0, 0); PG8_SCHED; PG8_LDA(At, 0, 0); PG8_STAGE(PG8_SA(1, 1), a1 + hstepA, voffA);
            PG8_WAIT_L(8); PG8_BAR; PG8_WAIT_L(0); PG8_MMA(0, 0, At, B0); PG8_BAR; PG8_SCHED;
            PG8_LDB(B1, 0, 1); PG8_STAGE(PG8_SB(0, 0), b2, voffB);
            PG8_BAR; PG8_WAIT_L(0); PG8_MMA(0, 1, At, B1); PG8_BAR;
            PG8_LDA(At, 0, 1); PG8_STAGE(PG8_SA(0, 0), a2, voffA);
            PG8_BAR; PG8_WAIT_L(0); PG8_MMA(1, 0, At, B0); PG8_BAR; PG8_SCHED;
            PG8_STAGE(PG8_SB(0, 1), b2 + hstepB, voffB);
            PG8_WAIT_V(6); PG8_BAR; PG8_MMA(1, 1, At, B1); PG8_BAR;
            PG8_LDB(B0, 1, 0); PG8_SCHED; PG8_LDA(At, 1, 0); PG8_STAGE(PG8_SA(0, 1), a2 + hstepA, voffA);
            PG8_WAIT_L(8); PG8_BAR; PG8_WAIT_L(0); PG8_MMA(0, 0, At, B0); PG8_BAR; PG8_SCHED;
            PG8_LDB(B1, 1, 1); PG8_STAGE(PG8_SB(1, 0), b3, voffB);
            PG8_BAR; PG8_WAIT_L(0); PG8_MMA(0, 1, At, B1); PG8_BAR;
            PG8_LDA(At, 1, 1); PG8_STAGE(PG8_SA(1, 0), a3, voffA);
            PG8_BAR; PG8_WAIT_L(0); PG8_MMA(1, 0, At, B0); PG8_BAR; PG8_SCHED;
            PG8_STAGE(PG8_SB(1, 1), b3 + hstepB, voffB);
            PG8_WAIT_V(6); PG8_BAR; PG8_MMA(1, 1, At, B1); PG8_BAR;
        }
        E(acc, cur, wr, wc, fr, fq, lds);
        if (!has_next) break;
#pragma unroll
        for (int a = 0; a < 2; ++a)
#pragma unroll
            for (int b = 0; b < 2; ++b)
#pragma unroll
                for (int m = 0; m < 4; ++m)
#pragma unroll
                    for (int n = 0; n < 2; ++n) acc[a][b][m][n] = (f32x4){zr, zr, zr, zr};
        cur = nxt; cA = nA; cB = nB; ++ui;
    }
    PG8_WAIT_V(0);
    if (wr == 0) PG8_BAR;
    PG8_BAR;
#undef PG8_SA
#undef PG8_SB
#undef PG8_STAGE
#undef PG8_LDA
#undef PG8_LDB
#undef PG8_MMA
#undef PG8_WAIT_V
#undef PG8_WAIT_L
#undef PG8_BAR
#undef PG8_SCHED
#undef PG8_ACOL
}

__device__ __forceinline__ float rstd_of(const float* rss, int row) {
    const f32x4* p = (const f32x4*)(rss + (size_t)row * 16); const f32x4 a = p[0], b = p[1], c = p[2], d = p[3];
    const float s = ((a[0] + a[1]) + (a[2] + a[3])) + ((b[0] + b[1]) + (b[2] + b[3])) + (((c[0] + c[1]) + (c[2] + c[3])) + ((d[0] + d[1]) + (d[2] + d[3])));
    return rsqrtf(s * (1.0f / 1024.0f) + EPS); }
__device__ __forceinline__ float rstd_of4(const float* rss, int row, int fq) {
    const f32x4 a = *(const f32x4*)(rss + (size_t)row * 16 + 4 * fq); float s = (a[0] + a[1]) + (a[2] + a[3]);
    s += __shfl_xor(s, 16); s += __shfl_xor(s, 32);
    return rsqrtf(s * (1.0f / 1024.0f) + EPS); }
__device__ __forceinline__ unsigned long long ep64(LAS unsigned char* lds, int k) {
    volatile LAS unsigned* t = (volatile LAS unsigned*)(lds + TAB_OFF + 1024); unsigned lo = t[2 * k], hi = t[2 * k + 1];
    lo = __builtin_amdgcn_readfirstlane(lo); hi = __builtin_amdgcn_readfirstlane(hi); return ((unsigned long long)hi << 32) | (unsigned long long)lo; }
#define EPP(T_, k) ((T_)(__attribute__((address_space(1))) char*)ep64(lds, (k)))

struct EpiSwiGLU {
    static constexpr bool PERM = true;
    __device__ __forceinline__ void operator()(const f32x4 (&acc)[2][2][4][2], const Unit& u, int wr, int wc, int fr, int fq, LAS unsigned char* lds) const {
        bf16_t* O = EPP(bf16_t*, 0); const float* rss = EPP(const float*, 1);
        const int row0 = u.pm * BM + wr * 64 + fr, j0 = u.pn * 128 + wc * 32 + 8 * fq;
#pragma unroll
        for (int ai = 0; ai < 2; ++ai)
#pragma unroll
            for (int m = 0; m < 4; ++m) { const int row = row0 + ai * HALF + m * 16; const float rs = rstd_of4(rss, row, fq);
                float h[8];
#pragma unroll
                for (int n = 0; n < 2; ++n)
#pragma unroll
                    for (int e = 0; e < 4; ++e) { const float gt = acc[ai][0][m][n][e] * rs, up = acc[ai][1][m][n][e] * rs; h[n * 4 + e] = gt * fast_sigmoid(gt) * up; }
                u32x4 w; w.x = cvt_pk_bf16(h[0], h[1]); w.y = cvt_pk_bf16(h[2], h[3]); w.z = cvt_pk_bf16(h[4], h[5]); w.w = cvt_pk_bf16(h[6], h[7]);
                *(u32x4*)(O + (size_t)row * DFF + j0) = w; }
    }
};
struct EpiProj {
    static constexpr bool PERM = true;
    __device__ __forceinline__ void operator()(const f32x4 (&acc)[2][2][4][2], const Unit& u, int wr, int wc, int fr, int fq, LAS unsigned char* lds) const {
        bf16_t* O = EPP(bf16_t*, 0); const float* rss = EPP(const float*, 1); const float* bias = EPP(const float*, 2); const int ldc = (int)ep64(lds, 3);
        const int row0 = u.pm * BM + wr * 64 + fr, col0 = u.pn * BM + wc * 32 + 8 * fq;
        f32x4 bv[2][2];
#pragma unroll
        for (int bj = 0; bj < 2; ++bj)
#pragma unroll
            for (int n = 0; n < 2; ++n) bv[bj][n] = bias ? *(const f32x4*)(bias + col0 + bj * HALF + 4 * n) : (f32x4){0.f, 0.f, 0.f, 0.f};
#pragma unroll
        for (int ai = 0; ai < 2; ++ai)
#pragma unroll
            for (int m = 0; m < 4; ++m) { const int row = row0 + ai * HALF + m * 16; const float rs = rss ? rstd_of4(rss, row, fq) : 1.0f;
#pragma unroll
                for (int bj = 0; bj < 2; ++bj) { const f32x4 v0 = acc[ai][bj][m][0] * rs + bv[bj][0], v1 = acc[ai][bj][m][1] * rs + bv[bj][1];
                    u32x4 w; w.x = cvt_pk_bf16(v0[0], v0[1]); w.y = cvt_pk_bf16(v0[2], v0[3]); w.z = cvt_pk_bf16(v1[0], v1[1]); w.w = cvt_pk_bf16(v1[2], v1[3]);
                    *(u32x4*)(O + (size_t)row * ldc + col0 + bj * HALF) = w; } }
    }
};
template <int MODE> struct EpiResid {
    static constexpr bool PERM = true;
    __device__ __forceinline__ void operator()(const f32x4 (&acc)[2][2][4][2], const Unit& u, int wr, int wc, int fr, int fq, LAS unsigned char* lds) const {
        const float* rss_in = EPP(const float*, 1); const float* bias = EPP(const float*, 2);
        const bf16_t* base = EPP(const bf16_t*, 3);
        bf16_t* hb = EPP(bf16_t*, 5); float* rss_out = EPP(float*, 6); const bf16_t* pp = EPP(const bf16_t*, 7); const float scale = __uint_as_float((unsigned)ep64(lds, 8));
        const int row0 = u.pm * BM + wr * 64 + fr, col0 = u.pn * BM + wc * 32 + 8 * fq;
        f32x4 bv[2][2];
#pragma unroll
        for (int bj = 0; bj < 2; ++bj)
#pragma unroll
            for (int n = 0; n < 2; ++n) bv[bj][n] = (MODE == 0 && bias) ? *(const f32x4*)(bias + col0 + bj * HALF + 4 * n) : (f32x4){0.f, 0.f, 0.f, 0.f};
#pragma unroll
        for (int ai = 0; ai < 2; ++ai)
#pragma unroll
            for (int m = 0; m < 4; ++m) { const int row = row0 + ai * HALF + m * 16; const size_t off = (size_t)row * D + col0;
                float rs = 1.0f; if (MODE == 1) rs = rstd_of4(rss_in, row, fq);
                float ss = 0.f;
#pragma unroll
                for (int bj = 0; bj < 2; ++bj) { const size_t o = off + bj * HALF; const u32x4 bw = *(const u32x4*)(base + o);
                    const float bs[8] = {bflo(bw.x), bfhi(bw.x), bflo(bw.y), bfhi(bw.y), bflo(bw.z), bfhi(bw.z), bflo(bw.w), bfhi(bw.w)};
                    float hn[8];
                    if (MODE == 0) {
#pragma unroll
                        for (int n = 0; n < 2; ++n)
#pragma unroll
                            for (int e = 0; e < 4; ++e) hn[4 * n + e] = bs[4 * n + e] + (acc[ai][bj][m][n][e] + bv[bj][n][e]) * scale;
                    } else { const u32x4 pw = *(const u32x4*)(pp + o);
                        const float pv[8] = {bflo(pw.x), bfhi(pw.x), bflo(pw.y), bfhi(pw.y), bflo(pw.z), bfhi(pw.z), bflo(pw.w), bfhi(pw.w)};
#pragma unroll
                        for (int n = 0; n < 2; ++n)
#pragma unroll
                            for (int e = 0; e < 4; ++e) hn[4 * n + e] = bs[4 * n + e] + fast_sigmoid(acc[ai][bj][m][n][e] * rs) * pv[4 * n + e]; }
                    u32x4 w; w.x = cvt_pk_bf16(hn[0], hn[1]); w.y = cvt_pk_bf16(hn[2], hn[3]); w.z = cvt_pk_bf16(hn[4], hn[5]); w.w = cvt_pk_bf16(hn[6], hn[7]); *(u32x4*)(hb + o) = w;
                    const float hr[8] = {bflo(w.x), bfhi(w.x), bflo(w.y), bfhi(w.y), bflo(w.z), bfhi(w.z), bflo(w.w), bfhi(w.w)};
                    ss += ((hr[0] * hr[0] + hr[1] * hr[1]) + (hr[2] * hr[2] + hr[3] * hr[3])) + ((hr[4] * hr[4] + hr[5] * hr[5]) + (hr[6] * hr[6] + hr[7] * hr[7])); }
                ss += __shfl_xor(ss, 16); ss += __shfl_xor(ss, 32);
                if (fq == 0) rss_out[(size_t)row * 16 + u.pn * 4 + wc] = ss; }
    }
};
struct EpiLruGates {
    static constexpr bool PERM = true;
    __device__ __forceinline__ void operator()(const f32x4 (&acc)[2][2][4][2], const Unit& u, int wr, int wc, int fr, int fq, LAS unsigned char* lds) const {
        const int grp = u.pn >> 1, d = grp >> 2, blk = grp & 3, c0 = blk * 256 + (u.pn & 1) * 128 + wc * 32 + 8 * fq;
        const int row0 = u.pm * BM + wr * 64 + fr;
        const bf16_t* xb = EPP(const bf16_t*, 0); bf16_t* LA = EPP(bf16_t*, 1 + d); bf16_t* BB = EPP(bf16_t*, 3 + d);
        const float* bx = EPP(const float*, 5); const float* ba = EPP(const float*, 6); const float* lsp = EPP(const float*, 7);
        f32x4 vbx[2], vba[2], vls[2];
#pragma unroll
        for (int n = 0; n < 2; ++n) { vbx[n] = *(const f32x4*)(bx + d * D + c0 + 4 * n); vba[n] = *(const f32x4*)(ba + d * D + c0 + 4 * n); vls[n] = *(const f32x4*)(lsp + d * D + c0 + 4 * n); }
#pragma unroll
        for (int ai = 0; ai < 2; ++ai)
#pragma unroll
            for (int m = 0; m < 4; ++m) { const int row = row0 + ai * HALF + m * 16; const size_t o = (size_t)row * D + c0;
                const bool first = d == 0 ? ((row & (LS - 1)) == 0 && row != LS) : ((row & (LS - 1)) == LS - 1 && row != LS - 1);
                const u32x4 xw = *(const u32x4*)(xb + o);
                const float xv[8] = {bflo(xw.x), bfhi(xw.x), bflo(xw.y), bfhi(xw.y), bflo(xw.z), bfhi(xw.z), bflo(xw.w), bfhi(xw.w)};
                float lo[8], bo[8];
#pragma unroll
                for (int n = 0; n < 2; ++n)
#pragma unroll
                    for (int e = 0; e < 4; ++e) { const int qd = 4 * n + e; const float gx = fast_sigmoid(acc[ai][0][m][n][e] + vbx[n][e]), ga = fast_sigmoid(acc[ai][1][m][n][e] + vba[n][e]);
                        const float l = ga * vls[n][e]; const float mult = first ? 1.0f : __builtin_amdgcn_sqrtf(fmaxf(1.0f - fast_exp(2.0f * l), 0.f)); lo[qd] = l; bo[qd] = mult * gx * xv[qd]; }
                u32x4 w; w.x = cvt_pk_bf16(lo[0], lo[1]); w.y = cvt_pk_bf16(lo[2], lo[3]); w.z = cvt_pk_bf16(lo[4], lo[5]); w.w = cvt_pk_bf16(lo[6], lo[7]); *(u32x4*)(LA + o) = w;
                w.x = cvt_pk_bf16(bo[0], bo[1]); w.y = cvt_pk_bf16(bo[2], bo[3]); w.z = cvt_pk_bf16(bo[4], bo[5]); w.w = cvt_pk_bf16(bo[6], bo[7]); *(u32x4*)(BB + o) = w; }
    }
};
#undef EPP
}


#define XB_TMO      128
#define XB_XCNT(j)  (256  + 64 * (j))
#define XB_XSUB(j)  (1280 + 64 * (j))
#define XB_XGEN(j)  (2304 + 64 * (j))
#define XB_TOP      3328
#define XB_TOPGEN   3392
#define XCD_BAR_WORDS 3456
#define XB_SPIN_CAP (1u << 22)
__device__ __forceinline__ unsigned xb_ld(unsigned* p)              { return __hip_atomic_load(p, __ATOMIC_RELAXED, __HIP_MEMORY_SCOPE_AGENT); }
__device__ __forceinline__ unsigned xb_add(unsigned* p, unsigned v) { return __hip_atomic_fetch_add(p, v, __ATOMIC_RELAXED, __HIP_MEMORY_SCOPE_AGENT); }
__device__ __forceinline__ unsigned xb_xcc_id() { return (unsigned)__builtin_amdgcn_s_getreg((3 << 11) | 20) & 0xFu; }
#define XB_SPIN(cond, bar) do { unsigned _sp = 0; while (cond) { __builtin_amdgcn_s_sleep(1); \
    if ((++_sp & 255u) == 0u) { if (xb_ld(&(bar)[XB_TMO])) break; if (_sp > XB_SPIN_CAP) { atomicAdd(&(bar)[XB_TMO], 1u); break; } } } } while (0)
__device__ __forceinline__ void xcd_barrier_complete(unsigned* bar, unsigned x, unsigned& nloc, unsigned& nx) {
    const unsigned G = gridDim.x * gridDim.y * gridDim.z;
    unsigned sum, cnt, mine, sp = 0u;
    for (;;) {
        sum = 0u; cnt = 0u; mine = 0u;
#pragma unroll
        for (unsigned j = 0; j < 16; ++j) { const unsigned c = xb_ld(&bar[XB_XCNT(j)]); sum += c; cnt += (c > 0u) ? 1u : 0u; mine = (j == x) ? c : mine; }
        if (sum == G) break;
        __builtin_amdgcn_s_sleep(1);
        if ((++sp & 255u) == 0u) { if (xb_ld(&bar[XB_TMO])) break; if (sp > XB_SPIN_CAP) { atomicAdd(&bar[XB_TMO], 1u); break; } }
    }
    nloc = mine > 0u ? mine : 1u; nx = cnt > 0u ? cnt : 1u;
}
__device__ __forceinline__ void xcd_barrier(unsigned* bar, volatile LAS unsigned* st) {
    asm volatile("s_waitcnt vmcnt(0)" ::: "memory");
    __syncthreads();
    if (threadIdx.x == 0) {
        const unsigned x = xb_xcc_id();
        __builtin_amdgcn_s_waitcnt(0);
        unsigned nloc = st[0], nx = st[1];
        if (nloc == 0u) { xcd_barrier_complete(bar, x, nloc, nx); st[0] = nloc; st[1] = nx; }
        const unsigned old = xb_add(&bar[XB_XSUB(x)], 1u);
        const unsigned gen = old / nloc;
        if (old + 1u == (gen + 1u) * nloc) {
            __builtin_amdgcn_fence(__ATOMIC_RELEASE, "agent");
            asm volatile("s_waitcnt vmcnt(0)" ::: "memory");
            const unsigned og = xb_add(&bar[XB_TOP], 1u);
            const unsigned tg = og / nx;
            if (og + 1u == (tg + 1u) * nx) xb_add(&bar[XB_TOPGEN], 1u);
            else XB_SPIN(xb_ld(&bar[XB_TOPGEN]) == tg, bar);
            __builtin_amdgcn_fence(__ATOMIC_ACQUIRE, "agent");
            xb_add(&bar[XB_XGEN(x)], 1u);
            asm volatile("s_waitcnt vmcnt(0)" ::: "memory");
        } else {
            XB_SPIN(xb_ld(&bar[XB_XGEN(x)]) == gen, bar);
            __builtin_amdgcn_fence(__ATOMIC_ACQUIRE, "agent");
            asm volatile("s_waitcnt vmcnt(0)" ::: "memory");
        }
    }
    __syncthreads();
}

struct Ctx { int tid, lane, wave, bid, nblk; LAS unsigned char* lds; };

__device__ __forceinline__ void convT(const Ctx& c, const float* W, int K, int N, int ldw, const float* gain, bf16_t* dst, int ldd, int G, int S, int off) {
    LAS float* tile = (LAS float*)c.lds;
    const int nk = K / 64, nn = N / 256, njobs = nk * nn;
    for (int job = c.bid; job < njobs; job += c.nblk) {
        const int kt = job / nn, ntile = job % nn, k0 = kt * 64, n0 = ntile * 256;
        f32x4 v[8];
#pragma unroll
        for (int i = 0; i < 8; ++i) { const int e = c.tid + i * NTHR, kk = e >> 6, n4 = (e & 63) * 4; v[i] = *(const f32x4*)(W + (size_t)(k0 + kk) * ldw + n0 + n4); if (gain) v[i] = v[i] * gain[k0 + kk]; }
        __syncthreads();
#pragma unroll
        for (int i = 0; i < 8; ++i) { const int e = c.tid + i * NTHR, kk = e >> 6, n4 = (e & 63) * 4; LAS float* tp = tile + kk * 257 + n4; tp[0] = v[i][0]; tp[1] = v[i][1]; tp[2] = v[i][2]; tp[3] = v[i][3]; }
        __syncthreads();
#pragma unroll
        for (int i = 0; i < 4; ++i) { const int e = c.tid + i * NTHR, n = e & 255, ks = (e >> 8) * 8;
            float x[8];
#pragma unroll
            for (int j = 0; j < 8; ++j) x[j] = tile[(ks + j) * 257 + n];
            u32x4 w; w.x = cvt_pk_bf16(x[0], x[1]); w.y = cvt_pk_bf16(x[2], x[3]); w.z = cvt_pk_bf16(x[4], x[5]); w.w = cvt_pk_bf16(x[6], x[7]);
            const int ng = n0 + n, drow = (ng / G) * S + (ng % G) + off;
            *(u32x4*)(dst + (size_t)drow * ldd + k0 + ks) = w; }
    }
    __syncthreads();
}

__device__ __forceinline__ void x_to_bf16(const Ctx& c, const float* xp, const float* xs, bf16_t* hb, float* rss) {
    const int gw = c.bid * 8 + c.wave, nw = c.nblk * 8;
    for (int row0 = gw * 2; row0 < T; row0 += nw * 2) {
        f32x4 v[2][4];
#pragma unroll
        for (int rr = 0; rr < 2; ++rr) { const int row = row0 + rr; const float* src = row < TP ? xp + (size_t)row * D : xs + (size_t)(row - TP) * D;
#pragma unroll
            for (int i = 0; i < 4; ++i) v[rr][i] = *(const f32x4*)(src + i * 256 + c.lane * 4); }
#pragma unroll
        for (int rr = 0; rr < 2; ++rr) { const int row = row0 + rr; float ss = 0.f;
#pragma unroll
            for (int i = 0; i < 4; ++i) { u32x2 w; w.x = cvt_pk_bf16(v[rr][i][0], v[rr][i][1]); w.y = cvt_pk_bf16(v[rr][i][2], v[rr][i][3]); *(u32x2*)(hb + (size_t)row * D + i * 256 + c.lane * 4) = w;
                const float a0 = bflo(w.x), a1 = bfhi(w.x), a2 = bflo(w.y), a3 = bfhi(w.y); ss += (a0 * a0 + a1 * a1) + (a2 * a2 + a3 * a3); }
#pragma unroll
            for (int o = 32; o >= 1; o >>= 1) ss += __shfl_xor(ss, o);
            if (c.lane < 16) rss[(size_t)row * 16 + c.lane] = c.lane == 0 ? ss : 0.f; }
    }
}
__device__ __forceinline__ void p_to_bf16(const Ctx& c, const float* pp_, const float* ps_, bf16_t* dst) {
    const size_t n8 = (size_t)T * PLE / 8, np8 = (size_t)TP * PLE / 8, stride = (size_t)c.nblk * NTHR;
    for (size_t i0 = (size_t)c.bid * NTHR + c.tid; i0 < n8; i0 += 4 * stride) {
        f32x4 a[4], b[4];
#pragma unroll
        for (int k = 0; k < 4; ++k) { const size_t i = i0 + k * stride; if (i < n8) { const float* src = i < np8 ? pp_ + i * 8 : ps_ + (i - np8) * 8; a[k] = *(const f32x4*)src; b[k] = *(const f32x4*)(src + 4); } }
#pragma unroll
        for (int k = 0; k < 4; ++k) { const size_t i = i0 + k * stride; if (i < n8) {
            u32x4 w; w.x = cvt_pk_bf16(a[k][0], a[k][1]); w.y = cvt_pk_bf16(a[k][2], a[k][3]); w.z = cvt_pk_bf16(b[k][0], b[k][1]); w.w = cvt_pk_bf16(b[k][2], b[k][3]);
            *(u32x4*)(dst + i * 8) = w; } }
    }
}
__device__ __forceinline__ void zero_f32(const Ctx& c, float* p, size_t n) {
    for (size_t i = ((size_t)c.bid * NTHR + c.tid) * 4; i < n; i += (size_t)c.nblk * NTHR * 4) *(f32x4*)(p + i) = (f32x4){0.f, 0.f, 0.f, 0.f};
}
__device__ __forceinline__ void seq_of(int row, int& s0, int& L) { if (row < TP) { s0 = 0; L = TP; } else { s0 = TP + ((row - TP) & ~(LS - 1)); L = LS; } }

__device__ __forceinline__ void hy_elem(const Ctx& c, const bf16_t* u, const float* cw, const float* cb, bf16_t* vv, bf16_t* x0c, bf16_t* vvT) {
    LAS bf16_t* tile = (LAS bf16_t*)c.lds;
    const int tr = c.tid >> 3, cg = c.tid & 7;
    for (int job = c.bid; job < (T / 256) * 16; job += c.nblk) {
        const int c0 = (job & 15) * 64, ch = c0 + cg * 8, rowj = (job >> 4) * 256;
        float wgt[3][3][8], bia[3][8];
#pragma unroll
        for (int part = 0; part < 3; ++part) { const int col = part * D + ch;
#pragma unroll
            for (int h2 = 0; h2 < 2; ++h2) { const f32x4 b4 = *(const f32x4*)(cb + col + 4 * h2);
#pragma unroll
                for (int e = 0; e < 4; ++e) bia[part][4 * h2 + e] = b4[e];
#pragma unroll
                for (int tap = 0; tap < 3; ++tap) { const f32x4 w4 = *(const f32x4*)(cw + tap * 3072 + col + 4 * h2);
#pragma unroll
                    for (int e = 0; e < 4; ++e) wgt[part][tap][4 * h2 + e] = w4[e]; } } }
        for (int tl = 0; tl < 4; ++tl) {
            const int row0 = rowj + tl * 64, row = row0 + tr;
            int s0, L; seq_of(row, s0, L); const bool hasp = row > s0, hasn = row < s0 + L - 1;
            float r[3][8];
#pragma unroll
            for (int part = 0; part < 3; ++part) { const int col = part * D + ch; const bf16_t* p = u + (size_t)row * 3072 + col;
                const u32x4 z4 = (u32x4){0u, 0u, 0u, 0u};
                const u32x4 wc_ = *(const u32x4*)p, wp = hasp ? *(const u32x4*)(p - 3072) : z4, wn = hasn ? *(const u32x4*)(p + 3072) : z4;
                const unsigned wcv[4] = {wc_.x, wc_.y, wc_.z, wc_.w}, wpv[4] = {wp.x, wp.y, wp.z, wp.w}, wnv[4] = {wn.x, wn.y, wn.z, wn.w};
#pragma unroll
                for (int e = 0; e < 4; ++e) {
                    r[part][2 * e] = bia[part][2 * e] + wgt[part][0][2 * e] * bflo(wpv[e]) + wgt[part][1][2 * e] * bflo(wcv[e]) + wgt[part][2][2 * e] * bflo(wnv[e]);
                    r[part][2 * e + 1] = bia[part][2 * e + 1] + wgt[part][0][2 * e + 1] * bfhi(wpv[e]) + wgt[part][1][2 * e + 1] * bfhi(wcv[e]) + wgt[part][2][2 * e + 1] * bfhi(wnv[e]); } }
            u32x4 w; w.x = cvt_pk_bf16(r[0][0], r[0][1]); w.y = cvt_pk_bf16(r[0][2], r[0][3]); w.z = cvt_pk_bf16(r[0][4], r[0][5]); w.w = cvt_pk_bf16(r[0][6], r[0][7]);
            *(u32x4*)(x0c + (size_t)row * D + ch) = w;
            w.x = cvt_pk_bf16(r[2][0] * r[1][0], r[2][1] * r[1][1]); w.y = cvt_pk_bf16(r[2][2] * r[1][2], r[2][3] * r[1][3]);
            w.z = cvt_pk_bf16(r[2][4] * r[1][4], r[2][5] * r[1][5]); w.w = cvt_pk_bf16(r[2][6] * r[1][6], r[2][7] * r[1][7]);
                __syncthreads();
            { const unsigned wv[4] = {w.x, w.y, w.z, w.w};
#pragma unroll
              for (int e = 0; e < 4; ++e) { tile[(cg * 8 + 2 * e) * 74 + tr] = (bf16_t)(wv[e] & 0xffffu); tile[(cg * 8 + 2 * e + 1) * 74 + tr] = (bf16_t)(wv[e] >> 16); } }
            __syncthreads();
            { const int cc = c.tid >> 3, tg = c.tid & 7; const LAS unsigned* tp = (const LAS unsigned*)(tile + cc * 74 + tg * 8); u32x4 v; v.x = tp[0]; v.y = tp[1]; v.z = tp[2]; v.w = tp[3];
              *(u32x4*)(vvT + (size_t)(c0 + cc) * T + row0 + tg * 8) = v; }
        }
    }
    __syncthreads();
}
__device__ __forceinline__ void hy_final(const Ctx& c, const bf16_t* yT, const bf16_t* vv, const bf16_t* x0c, const float* skip, bf16_t* yg) {
    LAS bf16_t* tile = (LAS bf16_t*)c.lds;
    for (int job = c.bid; job < (T / 64) * 16; job += c.nblk) {
        const int row0 = (job >> 4) * 64, c0 = (job & 15) * 64;
        __syncthreads();
        { const int cc = c.tid >> 3, tg = c.tid & 7; const u32x4 v = *(const u32x4*)(yT + (size_t)(c0 + cc) * T + row0 + tg * 8); const unsigned wv[4] = {v.x, v.y, v.z, v.w};
#pragma unroll
          for (int e = 0; e < 4; ++e) { tile[(tg * 8 + 2 * e) * 74 + cc] = (bf16_t)(wv[e] & 0xffffu); tile[(tg * 8 + 2 * e + 1) * 74 + cc] = (bf16_t)(wv[e] >> 16); } }
        __syncthreads();
        const int tr = c.tid >> 3, cg = c.tid & 7, row = row0 + tr, ch = c0 + cg * 8; const size_t o = (size_t)row * D + ch;
        const LAS unsigned* tp = (const LAS unsigned*)(tile + tr * 74 + cg * 8); u32x4 yv; yv.x = tp[0]; yv.y = tp[1]; yv.z = tp[2]; yv.w = tp[3];
        const u32x4 xw = *(const u32x4*)(x0c + o);
        u32x4 w;
        w.x = cvt_pk_bf16(bflo(yv.x) * bflo(xw.x), bfhi(yv.x) * bfhi(xw.x));
        w.y = cvt_pk_bf16(bflo(yv.y) * bflo(xw.y), bfhi(yv.y) * bfhi(xw.y));
        w.z = cvt_pk_bf16(bflo(yv.z) * bflo(xw.z), bfhi(yv.z) * bfhi(xw.z));
        w.w = cvt_pk_bf16(bflo(yv.w) * bflo(xw.w), bfhi(yv.w) * bfhi(xw.w));
        *(u32x4*)(yg + o) = w;
    }
    __syncthreads();
}
__device__ __forceinline__ void hy_filter(const Ctx& c, int L, size_t kbase, const float* w1, const float* b1, const float* w2, const float* b2, const float* w3, const float* b3,
                                          const float* freq, const bf16_t* woutB, const float* skip, bf16_t* FK) {
    const int lane = c.lane, wave = c.wave, r = lane & 31, h = lane >> 5;
    LAS bf16_t* h3b = (LAS bf16_t*)c.lds;
    const float fr = freq[lane], vb1 = b1[lane], vb2 = b2[lane], vb3 = b3[lane];
    const float dmin = -3.0701134573253945f, dmax = -15.350567286626972f;
    for (int job = c.bid; job < L / 32; job += c.nblk) {
        const int tb = job * 32, t0 = tb + wave * 4;
        float z[4];
#pragma unroll
        for (int tt = 0; tt < 4; ++tt) { const int t = t0 + tt; float v = 0.f;
            if (lane == 0) v = (float)t / (float)(L - 1);
            else if (lane <= 32) { const int bi = (lane - 1) & 15; const float fb = 1e-4f + (float)bi * ((15.0f - 1e-4f) / 15.0f); const float ang = (6.283185307179586f / (float)L) * (float)t; const float a = fb * ang;
                v = lane <= 16 ? hw_cos(a) : -hw_sin(a); }
            z[tt] = v; }
        float hh[4], a[4];
#pragma unroll
        for (int tt = 0; tt < 4; ++tt) a[tt] = vb1;
        for (int i = 0; i < 33; ++i) { const float w = w1[i * 64 + lane];
#pragma unroll
            for (int tt = 0; tt < 4; ++tt) a[tt] += __shfl(z[tt], i) * w; }
#pragma unroll
        for (int tt = 0; tt < 4; ++tt) { hh[tt] = hw_sin(fr * a[tt]); a[tt] = vb2; }
        for (int i = 0; i < 64; ++i) { const float w = w2[i * 64 + lane];
#pragma unroll
            for (int tt = 0; tt < 4; ++tt) a[tt] += __shfl(hh[tt], i) * w; }
#pragma unroll
        for (int tt = 0; tt < 4; ++tt) { hh[tt] = hw_sin(fr * a[tt]); a[tt] = vb3; }
        for (int i = 0; i < 64; ++i) { const float w = w3[i * 64 + lane];
#pragma unroll
            for (int tt = 0; tt < 4; ++tt) a[tt] += __shfl(hh[tt], i) * w; }
        __syncthreads();
#pragma unroll
        for (int tt = 0; tt < 4; ++tt) h3b[(wave * 4 + tt) * 72 + lane] = f2bf(hw_sin(fr * a[tt]));
        __syncthreads();
        bf16x8 Bf[4];
#pragma unroll
        for (int s = 0; s < 4; ++s) Bf[s] = *(const LAS bf16x8*)(h3b + r * 72 + 16 * s + 8 * h);
        const int t = tb + r; const float tn = (float)t / (float)(L - 1);
        for (int nt = 0; nt < 8; ++nt) {
            const int n0 = wave * 256 + nt * 32;
            bf16x8 Af[4];
#pragma unroll
            for (int s = 0; s < 4; ++s) Af[s] = *(const bf16x8*)(woutB + (size_t)(n0 + r) * 64 + 16 * s + 8 * h);
            f32x16 acc;
#pragma unroll
            for (int i = 0; i < 16; ++i) acc[i] = 0.f;
#pragma unroll
            for (int s = 0; s < 4; ++s) acc = __builtin_amdgcn_mfma_f32_32x32x16_bf16(Af[s], Bf[s], acc, 0, 0, 0);
            const int dir = n0 >> 10;
#pragma unroll
            for (int i = 0; i < 16; ++i) { const int n = n0 + (i & 3) + 8 * (i >> 2) + 4 * h, ch = n & 1023;
                const float delta = fabsf(dmin + (float)ch * ((dmax - dmin) / 1023.0f));
                const bool zero = (dir == 1 && t == 0); const int idx = dir == 0 ? L - t : (zero ? 0 : L + t);
                FK[kbase + (size_t)ch * 2 * L + idx] = zero ? (bf16_t)0 : f2bf(acc[i] * fast_exp(-tn * delta) + ((dir == 0 && t == 0) ? skip[ch] : 0.f)); }
        }
    }
    __syncthreads();
}
template <int RHO> __device__ __forceinline__ u32x4 kr_shift(const u32x4 lo, const u32x4 hi) {
    const unsigned d[8] = {lo.x, lo.y, lo.z, lo.w, hi.x, hi.y, hi.z, hi.w};
    u32x4 o; unsigned ov[4];
#pragma unroll
    for (int k = 0; k < 4; ++k) {
        if (RHO % 2 == 0) ov[k] = d[4 - RHO / 2 + k];
        else ov[k] = __builtin_amdgcn_alignbit(d[4 - (RHO - 1) / 2 + k], d[3 - (RHO - 1) / 2 + k], 16);
    }
    o.x = ov[0]; o.y = ov[1]; o.z = ov[2]; o.w = ov[3]; return o;
}
template <bool PROMPT>
__device__ __forceinline__ void longconv_item(const Ctx& c, int ch, const bf16_t* vvT, const bf16_t* KR, bf16_t* yT) {
    constexpr int L = PROMPT ? TP : LS, NB = L / 256, NSEQ = PROMPT ? 1 : 4, VLEN = L + 768;
    constexpr int KB_OFF = NSEQ * VLEN * 2, KB_BYTES = (2 * L + (2 * L / 256) * 8) * 2, RB_OFF = KB_OFF + KB_BYTES;
    constexpr int NSTEPS = (L + 256) / 16, KSPLIT = PROMPT ? 8 : 4, PER = NSTEPS / KSPLIT;
    static_assert(RB_OFF + 32768 <= TAB_OFF && NSTEPS % KSPLIT == 0 && PER % 2 == 0, "long-conv LDS map");
    LAS unsigned char* lds = c.lds;
    const bf16_t* kr = KR + (PROMPT ? (size_t)ch * (2 * TP) : (size_t)D * (2 * TP) + (size_t)ch * (2 * LS));
    const size_t tok0 = (size_t)ch * T + (PROMPT ? 0 : TP);
    const int lane = c.lane, wave = c.wave, r = lane & 31, h = lane >> 5;
    __syncthreads();
#pragma unroll
    for (int s = 0; s < NSEQ; ++s) {
        for (int i = c.tid; i < 96; i += NTHR) { const int idx = i < 32 ? i * 8 : 256 + L + (i - 32) * 8; *(LAS u32x4*)(lds + (s * VLEN + idx) * 2) = (u32x4){0u, 0u, 0u, 0u}; }
        for (int i = c.tid; i < L / 8; i += NTHR) *(LAS u32x4*)(lds + (s * VLEN + 256 + i * 8) * 2) = *(const u32x4*)(vvT + tok0 + (size_t)s * L + i * 8);
    }
    constexpr int NG = 2 * L / 8 / NTHR;
    u32x4 klo[NG], khi[NG];
#pragma unroll
    for (int k = 0; k < NG; ++k) { const int X0 = (c.tid + NTHR * k) * 8; khi[k] = *(const u32x4*)(kr + X0); klo[k] = (u32x4){0u, 0u, 0u, 0u}; if (X0 >= 8) klo[k] = *(const u32x4*)(kr + X0 - 8); }
#define KR_STAGE(R) _Pragma("unroll") for (int k = 0; k < NG; ++k) { const int X0 = (c.tid + NTHR * k) * 8; *(LAS u32x4*)(lds + KB_OFF + (X0 + (X0 >> 8) * 8) * 2) = kr_shift<R>(klo[k], khi[k]); }
    float yst[4]; unsigned ywd[4];
    for (int rho = 0; rho < 8; ++rho) {
        __syncthreads();
        switch (rho) { case 0: { KR_STAGE(0) } break; case 1: { KR_STAGE(1) } break; case 2: { KR_STAGE(2) } break; case 3: { KR_STAGE(3) } break;
                       case 4: { KR_STAGE(4) } break; case 5: { KR_STAGE(5) } break; case 6: { KR_STAGE(6) } break; default: { KR_STAGE(7) } break; }
        __syncthreads();
        f32x16 acc0, acc1;
#pragma unroll
        for (int i = 0; i < 16; ++i) { acc0[i] = 0.f; acc1[i] = 0.f; }
        const int q = PROMPT ? wave : (wave & 3), p = PROMPT ? 0 : (wave >> 2);
        if (PROMPT) {
            const int bb = (8 * r + 8 * h) * 2, ab0 = KB_OFF + (264 * (NB - r - 1) + 8 * h) * 2, ab1 = KB_OFF + (264 * (NB - 32 - r - 1) + 8 * h) * 2;
#define LC_LD(X, Y, Z, ST) { const int kp_ = 16 * (ST), ao_ = 2 * (kp_ + 8 * (kp_ >> 8)), bo_ = 2 * kp_; X = *(const LAS bf16x8*)(lds + bb + bo_); Y = *(const LAS bf16x8*)(lds + ab0 + ao_); Z = *(const LAS bf16x8*)(lds + ab1 + ao_); }
            const int st0 = q * PER, st1 = st0 + PER;
            bf16x8 Ba, A0a, A1a, Bb, A0b, A1b;
            LC_LD(Ba, A0a, A1a, st0);
            for (int st = st0; st < st1; st += 2) {
                LC_LD(Bb, A0b, A1b, st + 1);
                acc0 = __builtin_amdgcn_mfma_f32_32x32x16_bf16(A0a, Ba, acc0, 0, 0, 0); acc1 = __builtin_amdgcn_mfma_f32_32x32x16_bf16(A1a, Ba, acc1, 0, 0, 0);
                { const int sn = st + 2 < st1 ? st + 2 : st1 - 1; LC_LD(Ba, A0a, A1a, sn); }
                acc0 = __builtin_amdgcn_mfma_f32_32x32x16_bf16(A0b, Bb, acc0, 0, 0, 0); acc1 = __builtin_amdgcn_mfma_f32_32x32x16_bf16(A1b, Bb, acc1, 0, 0, 0);
            }
#undef LC_LD
        } else {
            const int ab = KB_OFF + (264 * (NB - r - 1) + 8 * h) * 2, bb0 = ((2 * p) * VLEN + 8 * r + 8 * h) * 2, bb1 = ((2 * p + 1) * VLEN + 8 * r + 8 * h) * 2;
#define LC_LD(X, Y, Z, ST) { const int kp_ = 16 * (ST), ao_ = 2 * (kp_ + 8 * (kp_ >> 8)), bo_ = 2 * kp_; X = *(const LAS bf16x8*)(lds + ab + ao_); Y = *(const LAS bf16x8*)(lds + bb0 + bo_); Z = *(const LAS bf16x8*)(lds + bb1 + bo_); }
            const int st0 = q * PER, st1 = st0 + PER;
            bf16x8 Aa, B0a, B1a, Ab, B0b, B1b;
            LC_LD(Aa, B0a, B1a, st0);
            for (int st = st0; st < st1; st += 2) {
                LC_LD(Ab, B0b, B1b, st + 1);
                acc0 = __builtin_amdgcn_mfma_f32_32x32x16_bf16(Aa, B0a, acc0, 0, 0, 0); acc1 = __builtin_amdgcn_mfma_f32_32x32x16_bf16(Aa, B1a, acc1, 0, 0, 0);
                { const int sn = st + 2 < st1 ? st + 2 : st1 - 1; LC_LD(Aa, B0a, B1a, sn); }
                acc0 = __builtin_amdgcn_mfma_f32_32x32x16_bf16(Ab, B0b, acc0, 0, 0, 0); acc1 = __builtin_amdgcn_mfma_f32_32x32x16_bf16(Ab, B1b, acc1, 0, 0, 0);
            }
#undef LC_LD
        }
        LAS float* rb = (LAS float*)(lds + RB_OFF);
#pragma unroll
        for (int j = 0; j < 2; ++j) {
#pragma unroll
            for (int i = 0; i < 16; ++i) rb[wave * 1024 + i * 64 + lane] = j == 0 ? acc0[i] : acc1[i];
            __syncthreads();
            if (PROMPT) {
#pragma unroll
                for (int k2 = 0; k2 < 2; ++k2) { const int e = c.tid + NTHR * k2, v = j * 2 + k2; float s = 0.f;
#pragma unroll
                    for (int w = 0; w < 8; ++w) s += rb[w * 1024 + e];
                    if ((rho & 1) == 0) yst[v] = s;
                    else { const unsigned pw = cvt_pk_bf16(yst[v], s);
                        if ((rho & 2) == 0) ywd[v] = pw;
                        else { const int i = e >> 6, l = e & 63, m = (i & 3) + 8 * (i >> 2) + 4 * (l >> 5), n = l & 31, t0 = 256 * (32 * j + m) + 8 * n + (rho & 4);
                            *(u32x2*)((char*)yT + ((unsigned)tok0 + (unsigned)t0) * 2u) = (u32x2){ywd[v], pw}; } } }
            } else {
#pragma unroll
                for (int k2 = 0; k2 < 4; ++k2) { const int idx = c.tid + NTHR * k2, pp = idx >> 10, e = idx & 1023; float s = 0.f;
#pragma unroll
                    for (int w = 0; w < 4; ++w) s += rb[(pp * 4 + w) * 1024 + e];
                    const int i = e >> 6, l = e & 63, m = (i & 3) + 8 * (i >> 2) + 4 * (l >> 5), n = l & 31, t = 256 * m + 8 * n + rho;
                    yT[tok0 + (size_t)(2 * pp + j) * L + t] = f2bf(s); }
            }
            __syncthreads();
        }
    }
}
#undef KR_STAGE
__device__ __forceinline__ void longconv_sample2(const Ctx& c, int ch, const bf16_t* vvT, const bf16_t* KR, bf16_t* yT) {
    constexpr int L = LS, NB = L / 256, NSEQ = 4, VLEN = L + 768;
    constexpr int KB_OFF = NSEQ * VLEN * 2, KB_BYTES = (2 * L + (2 * L / 256) * 8) * 2;
    constexpr int NSTEPS = (L + 256) / 16, PER = NSTEPS / 4;
    static_assert(KB_OFF + 2 * KB_BYTES <= TAB_OFF && KB_BYTES >= 32768 && NSTEPS % 4 == 0 && PER % 2 == 0, "long-conv LDS map (sample)");
    LAS unsigned char* lds = c.lds;
    const bf16_t* kr = KR + (size_t)D * (2 * TP) + (size_t)ch * (2 * LS);
    const size_t tok0 = (size_t)ch * T + TP;
    const int lane = c.lane, wave = c.wave, r = lane & 31, h = lane >> 5;
    __syncthreads();
#pragma unroll
    for (int s = 0; s < NSEQ; ++s) {
        for (int i = c.tid; i < 96; i += NTHR) { const int idx = i < 32 ? i * 8 : 256 + L + (i - 32) * 8; *(LAS u32x4*)(lds + (s * VLEN + idx) * 2) = (u32x4){0u, 0u, 0u, 0u}; }
        for (int i = c.tid; i < L / 8; i += NTHR) *(LAS u32x4*)(lds + (s * VLEN + 256 + i * 8) * 2) = *(const u32x4*)(vvT + tok0 + (size_t)s * L + i * 8);
    }
    constexpr int NG = 2 * L / 8 / NTHR;
    u32x4 klo[NG], khi[NG];
#pragma unroll
    for (int k = 0; k < NG; ++k) { const int X0 = (c.tid + NTHR * k) * 8; khi[k] = *(const u32x4*)(kr + X0); klo[k] = (u32x4){0u, 0u, 0u, 0u}; if (X0 >= 8) klo[k] = *(const u32x4*)(kr + X0 - 8); }
    float yst[8]; unsigned ywd[8];
#define KR_STAGE2(R) _Pragma("unroll") for (int k = 0; k < NG; ++k) { const int X0 = (c.tid + NTHR * k) * 8, P_ = (X0 + (X0 >> 8) * 8) * 2; \
        *(LAS u32x4*)(lds + KB_OFF + P_) = kr_shift<R>(klo[k], khi[k]); *(LAS u32x4*)(lds + KB_OFF + KB_BYTES + P_) = kr_shift<R + 1>(klo[k], khi[k]); }
    for (int rp = 0; rp < 4; ++rp) {
        __syncthreads();
        switch (rp) { case 0: { KR_STAGE2(0) } break; case 1: { KR_STAGE2(2) } break; case 2: { KR_STAGE2(4) } break; default: { KR_STAGE2(6) } break; }
        __syncthreads();
        f32x16 acc00, acc01, acc10, acc11;
#pragma unroll
        for (int i = 0; i < 16; ++i) { acc00[i] = 0.f; acc01[i] = 0.f; acc10[i] = 0.f; acc11[i] = 0.f; }
        const int q = wave & 3, p = wave >> 2;
        const int aba = KB_OFF + (264 * (NB - r - 1) + 8 * h) * 2, abb = aba + KB_BYTES, bb0 = ((2 * p) * VLEN + 8 * r + 8 * h) * 2, bb1 = ((2 * p + 1) * VLEN + 8 * r + 8 * h) * 2;
#define LC_LD(W, X, Y, Z, ST) { const int kp_ = 16 * (ST), ao_ = 2 * (kp_ + 8 * (kp_ >> 8)), bo_ = 2 * kp_; W = *(const LAS bf16x8*)(lds + aba + ao_); X = *(const LAS bf16x8*)(lds + abb + ao_); \
            Y = *(const LAS bf16x8*)(lds + bb0 + bo_); Z = *(const LAS bf16x8*)(lds + bb1 + bo_); }
#define LC_MM(W, X, Y, Z) { acc00 = __builtin_amdgcn_mfma_f32_32x32x16_bf16(W, Y, acc00, 0, 0, 0); acc01 = __builtin_amdgcn_mfma_f32_32x32x16_bf16(W, Z, acc01, 0, 0, 0); \
            acc10 = __builtin_amdgcn_mfma_f32_32x32x16_bf16(X, Y, acc10, 0, 0, 0); acc11 = __builtin_amdgcn_mfma_f32_32x32x16_bf16(X, Z, acc11, 0, 0, 0); }
        const int st0 = q * PER, st1 = st0 + PER;
        bf16x8 Aa0, Ab0, B00, B10, Aa1, Ab1, B01, B11;
        LC_LD(Aa0, Ab0, B00, B10, st0);
        for (int st = st0; st < st1; st += 2) {
            LC_LD(Aa1, Ab1, B01, B11, st + 1);
            LC_MM(Aa0, Ab0, B00, B10);
            { const int sn = st + 2 < st1 ? st + 2 : st1 - 1; LC_LD(Aa0, Ab0, B00, B10, sn); }
            LC_MM(Aa1, Ab1, B01, B11);
        }
#undef LC_LD
#undef LC_MM
        __syncthreads();
        LAS float* rb = (LAS float*)(lds + KB_OFF);
        static_assert(2 * KB_BYTES >= 65536, "reduce buffer must fit in the two filter copies");
#pragma unroll
        for (int rr = 0; rr < 2; ++rr) {
            if (rr) __syncthreads();
#pragma unroll
            for (int i = 0; i < 16; ++i) { rb[wave * 2048 + i * 64 + lane] = rr == 0 ? acc00[i] : acc10[i]; rb[wave * 2048 + 1024 + i * 64 + lane] = rr == 0 ? acc01[i] : acc11[i]; }
            __syncthreads();
#pragma unroll
            for (int k2 = 0; k2 < 4; ++k2)
#pragma unroll
                for (int sb = 0; sb < 2; ++sb) { const int idx = c.tid + NTHR * k2, pp = idx >> 10, e = idx & 1023, v = k2 * 2 + sb; float s = 0.f;
#pragma unroll
                    for (int w = 0; w < 4; ++w) s += rb[(pp * 4 + w) * 2048 + sb * 1024 + e];
                    if (rr == 0) yst[v] = s;
                    else { const unsigned pw = cvt_pk_bf16(yst[v], s);
                        if ((rp & 1) == 0) ywd[v] = pw;
                        else { const int i = e >> 6, l = e & 63, m = (i & 3) + 8 * (i >> 2) + 4 * (l >> 5), n = l & 31, t0 = 256 * m + 8 * n + 2 * (rp & 2);
                            *(u32x2*)((char*)yT + ((unsigned)tok0 + (unsigned)((2 * pp + sb) * L + t0)) * 2u) = (u32x2){ywd[v], pw}; } } }
        }
    }
#undef KR_STAGE2
}
__device__ __forceinline__ void hy_longconv(const Ctx& c, const bf16_t* vvT, const bf16_t* KR, bf16_t* yT) {
    for (int item = c.bid; item < 2 * D; item += c.nblk) {
        if (item < D) longconv_item<true>(c, item, vvT, KR, yT); else longconv_sample2(c, item - D, vvT, KR, yT);
    }
    __syncthreads();
}

__device__ __forceinline__ float dpp_xor1(float x) { return __int_as_float(__builtin_amdgcn_update_dpp(0, __float_as_int(x), 0xB1, 0xF, 0xF, true)); }
__device__ __forceinline__ float dpp_xor2(float x) { return __int_as_float(__builtin_amdgcn_update_dpp(0, __float_as_int(x), 0x4E, 0xF, 0xF, true)); }
__device__ __forceinline__ void na_attn(const Ctx& c, const bf16_t* qkv, const float* rpb, bf16_t* o) {
    LAS unsigned char* KV = c.lds;
    LAS bf16_t* VT = (LAS bf16_t*)(c.lds + 40960);
    constexpr int VP = 52, VH = 32 * VP + 8;
    LAS float* rp = (LAS float*)(c.lds + 40960 + 16 * VH * 2);
    int hh_loaded = -1;
    const int ql = c.lane & 31, h = c.lane >> 5;
    const bool xmap = false; const int nsteps = (3072 + c.nblk - 1) / c.nblk;
    for (int stp = 0; stp < nsteps; ++stp) {
        int hh, ch2, grow;
        if (xmap) { const int x = c.bid & 7, lb = c.bid >> 3; grow = 96 * x + 8 * stp + (lb >> 2); hh = (lb >> 1) & 1; ch2 = lb & 1; }
        else { const int it = c.bid + stp * c.nblk; if (it >= 3072) break; grow = it >> 2; hh = (it >> 1) & 1; ch2 = it & 1; }
        if (hh != hh_loaded) { __syncthreads(); for (int i = c.tid; i < 16 * 15 * 31; i += NTHR) rp[i] = rpb[hh * (16 * 15 * 31) + i] * 1.44269504089f; hh_loaded = hh; }
        const int row_tok = grow * 64; int s0, L; seq_of(row_tok, s0, L);
        const int rows = L / 64, r = (row_tok - s0) / 64;
        int rs = r - 4; rs = rs < 0 ? 0 : (rs > rows - 8 ? rows - 8 : rs);
        const int kcb0 = ch2 ? 24 : 0;
        const int qc = ch2 * 32 + ql; int qsl = qc - 8; qsl = qsl < 0 ? 0 : (qsl > 48 ? 48 : qsl);
        bf16x8 Qf[2][2]; f32x16 O[2]; float mrun[2], lrun[2];
#pragma unroll
        for (int e = 0; e < 2; ++e) { const int hd = hh * 16 + 2 * c.wave + e;
#pragma unroll
            for (int s = 0; s < 2; ++s) Qf[e][s] = *(const bf16x8*)(qkv + (size_t)(row_tok + qc) * 3072 + hd * 32 + 16 * s + 8 * h);
#pragma unroll
            for (int i = 0; i < 16; ++i) O[e][i] = 0.f;
            mrun[e] = -1e30f; lrun[e] = 0.f; }
        u32x4 pf[10];
        const char* gb = (const char*)qkv; const unsigned goff = ((unsigned)(s0 + kcb0) * 3072u + 1024u + (unsigned)hh * 512u + (unsigned)(c.tid & 63) * 8u) * 2u;
#define NA_ISSUE(KROW) _Pragma("unroll") for (int k = 0; k < 10; ++k) { const int seg = (c.tid >> 6) + 8 * k, kv = seg >= 40 ? 1 : 0, ci = seg - 40 * kv; \
            pf[k] = *(const u32x4*)(gb + (goff + (unsigned)((KROW) * 64 + ci) * 6144u + (unsigned)kv * 2048u)); }
        NA_ISSUE(rs);
        for (int kr = 0; kr < 8; ++kr) {
            const int krow = rs + kr, dr = krow - r + 7;
            __syncthreads();
#pragma unroll
            for (int k = 0; k < 10; ++k) { const int seg = (c.tid >> 6) + 8 * k;
                if (seg < 40) *(LAS u32x4*)(KV + seg * 1024 + (c.tid & 63) * 16) = pf[k];
                else { const int ci = seg - 40, chunk = c.tid & 63; LAS bf16_t* vp = VT + (chunk >> 2) * VH + ((chunk & 3) * 8) * VP + ci; const unsigned wv[4] = {pf[k].x, pf[k].y, pf[k].z, pf[k].w};
#pragma unroll
                    for (int j2 = 0; j2 < 4; ++j2) { vp[(2 * j2) * VP] = (bf16_t)(wv[j2] & 0xffffu); vp[(2 * j2 + 1) * VP] = (bf16_t)(wv[j2] >> 16); } } }
            if (kr < 7) { NA_ISSUE(krow + 1); }
            __syncthreads();
#pragma unroll
            for (int e = 0; e < 2; ++e) {
                const int hl = 2 * c.wave + e; const LAS float* bp = rp + (hl * 15 + dr) * 31;
                f32x16 S0, S1;
#pragma unroll
                for (int i = 0; i < 16; ++i) { S0[i] = 0.f; S1[i] = 0.f; }
#pragma unroll
                for (int s = 0; s < 2; ++s) {
                    const bf16x8 A0 = *(const LAS bf16x8*)(KV + ql * 1024 + hl * 64 + (16 * s + 8 * h) * 2), A1 = *(const LAS bf16x8*)(KV + (8 + ql) * 1024 + hl * 64 + (16 * s + 8 * h) * 2);
                    S0 = __builtin_amdgcn_mfma_f32_32x32x16_bf16(A0, Qf[e][s], S0, 0, 0, 0); S1 = __builtin_amdgcn_mfma_f32_32x32x16_bf16(A1, Qf[e][s], S1, 0, 0, 0); }
                const float sc = 0.17677669529663687f * 1.44269504089f;
                float mloc = -1e30f;
#pragma unroll
                for (int i = 0; i < 16; ++i) { const int ci = (i & 3) + 8 * (i >> 2) + 4 * h;
                    { const int kcol = kcb0 + ci; const bool ok = kcol >= qsl && kcol < qsl + 16; const int dc = ok ? kcol - qc + 15 : 0; const float v = ok ? S0[i] * sc + bp[dc] : -1e30f; S0[i] = v; mloc = fmaxf(mloc, v); }
                    if (i >= 12) {
                      const int kcol = kcb0 + 8 + ci; const bool ok = kcol >= qsl && kcol < qsl + 16; const int dc = ok ? kcol - qc + 15 : 0; const float v = ok ? S1[i] * sc + bp[dc] : -1e30f; S1[i] = v; mloc = fmaxf(mloc, v); } }
                mloc = fmaxf(mloc, __shfl_xor(mloc, 32));
                const float mn = fmaxf(mrun[e], mloc), corr = __builtin_amdgcn_exp2f(mrun[e] - mn); mrun[e] = mn;
                float lsum = 0.f;
#pragma unroll
                for (int i = 0; i < 16; ++i) { O[e][i] *= corr; S0[i] = __builtin_amdgcn_exp2f(S0[i] - mn); lsum += S0[i];
                    if (i >= 12) { S1[i] = __builtin_amdgcn_exp2f(S1[i] - mn); lsum += S1[i]; } else S1[i] = 0.f; }
                lrun[e] = lrun[e] * corr + lsum;
                const LAS bf16_t* vb = VT + hl * VH + ql * VP + 4 * h;
#pragma unroll
                for (int kt = 0; kt < 2; ++kt)
#pragma unroll
                    for (int s = kt; s < 2; ++s) {
                        u32x4 pw;
                        if (kt == 0) { pw.x = cvt_pk_bf16(S0[8 * s], S0[8 * s + 1]); pw.y = cvt_pk_bf16(S0[8 * s + 2], S0[8 * s + 3]); pw.z = cvt_pk_bf16(S0[8 * s + 4], S0[8 * s + 5]); pw.w = cvt_pk_bf16(S0[8 * s + 6], S0[8 * s + 7]); }
                        else { pw.x = cvt_pk_bf16(S1[8 * s], S1[8 * s + 1]); pw.y = cvt_pk_bf16(S1[8 * s + 2], S1[8 * s + 3]); pw.z = cvt_pk_bf16(S1[8 * s + 4], S1[8 * s + 5]); pw.w = cvt_pk_bf16(S1[8 * s + 6], S1[8 * s + 7]); }
                        const u32x2 va = *(const LAS u32x2*)(vb + kt * 8 + 16 * s), vc = *(const LAS u32x2*)(vb + kt * 8 + 16 * s + 8);
                        const u32x4 vq = (u32x4){va.x, va.y, vc.x, vc.y};
                        O[e] = __builtin_amdgcn_mfma_f32_32x32x16_bf16(__builtin_bit_cast(bf16x8, vq), __builtin_bit_cast(bf16x8, pw), O[e], 0, 0, 0);
                    }
            }
        }
#undef NA_ISSUE
#pragma unroll
        for (int e = 0; e < 2; ++e) { const int hd = hh * 16 + 2 * c.wave + e; const float lt = lrun[e] + __shfl_xor(lrun[e], 32), inv = 1.0f / lt;
            bf16_t* op = o + (size_t)(row_tok + qc) * D + hd * 32 + 4 * h;
#pragma unroll
            for (int g = 0; g < 4; ++g) { u32x2 w; w.x = cvt_pk_bf16(O[e][4 * g] * inv, O[e][4 * g + 1] * inv); w.y = cvt_pk_bf16(O[e][4 * g + 2] * inv, O[e][4 * g + 3] * inv); *(u32x2*)(op + 8 * g) = w; } }
    }
    __syncthreads();
}

__device__ __forceinline__ float gelu_tanh(float g) { return 0.5f * g * (1.0f + fast_tanh(0.7978845608028654f * (g + 0.044715f * g * g * g))); }
__device__ __forceinline__ void lru_elem(const Ctx& c, const bf16_t* u, const float* cw, const float* cb, bf16_t* xb, bf16_t* gb) {
    const int ch = (c.tid & 127) * 8, rsub = c.tid >> 7;
    float wgt[4][8], bia[8];
#pragma unroll
    for (int h2 = 0; h2 < 2; ++h2) { const f32x4 b4 = *(const f32x4*)(cb + ch + 4 * h2);
#pragma unroll
        for (int e = 0; e < 4; ++e) bia[4 * h2 + e] = b4[e];
#pragma unroll
        for (int tap = 0; tap < 4; ++tap) { const f32x4 w4 = *(const f32x4*)(cw + tap * D + ch + 4 * h2);
#pragma unroll
            for (int e = 0; e < 4; ++e) wgt[tap][4 * h2 + e] = w4[e]; } }
    for (int slab = c.bid; slab < T / 192; slab += c.nblk) {
        for (int k = 0; k < 48; ++k) {
            const int row = slab * 192 + rsub + 4 * k; int s0, L; seq_of(row, s0, L); const int t = row - s0;
            const bf16_t* p = u + (size_t)row * 2048 + ch;
            const u32x4 gw_ = *(const u32x4*)p; const unsigned gv[4] = {gw_.x, gw_.y, gw_.z, gw_.w};
            u32x4 w;
            w.x = cvt_pk_bf16(gelu_tanh(bflo(gv[0])), gelu_tanh(bfhi(gv[0]))); w.y = cvt_pk_bf16(gelu_tanh(bflo(gv[1])), gelu_tanh(bfhi(gv[1])));
            w.z = cvt_pk_bf16(gelu_tanh(bflo(gv[2])), gelu_tanh(bfhi(gv[2]))); w.w = cvt_pk_bf16(gelu_tanh(bflo(gv[3])), gelu_tanh(bfhi(gv[3])));
            *(u32x4*)(gb + (size_t)row * D + ch) = w;
            float a[8];
#pragma unroll
            for (int e = 0; e < 8; ++e) a[e] = bia[e];
#pragma unroll
            for (int j = 0; j < 4; ++j) { const int tt = t + j - 2; u32x4 xw = (u32x4){0u, 0u, 0u, 0u}; if (tt >= 0 && tt < L) xw = *(const u32x4*)(p + 1024 + (ptrdiff_t)(j - 2) * 2048);
                const unsigned xv[4] = {xw.x, xw.y, xw.z, xw.w};
#pragma unroll
                for (int e = 0; e < 4; ++e) { a[2 * e] += wgt[j][2 * e] * bflo(xv[e]); a[2 * e + 1] += wgt[j][2 * e + 1] * bfhi(xv[e]); } }
            w.x = cvt_pk_bf16(a[0], a[1]); w.y = cvt_pk_bf16(a[2], a[3]); w.z = cvt_pk_bf16(a[4], a[5]); w.w = cvt_pk_bf16(a[6], a[7]);
            *(u32x4*)(xb + (size_t)row * D + ch) = w;
        }
    }
}
constexpr int CL = 64, NCH = T / CL;
#define UNPK8(W_, f) const float f[8] = {bflo((W_).x), bfhi((W_).x), bflo((W_).y), bfhi((W_).y), bflo((W_).z), bfhi((W_).z), bflo((W_).w), bfhi((W_).w)}
__device__ __forceinline__ void lru_scan1(const Ctx& c, const bf16_t* la0, const bf16_t* bb0, const bf16_t* la1, const bf16_t* bb1, f32x2* agg) {
    const int n = NCH * (D / 8);
    for (int i = c.bid * NTHR + c.tid; i < n; i += c.nblk * NTHR) {
        const int ck = i / (D / 8), ch = (i % (D / 8)) * 8; const size_t base = (size_t)ck * CL * D + ch;
#pragma unroll
        for (int dir = 0; dir < 2; ++dir) {
            const bf16_t* la = dir ? la1 : la0; const bf16_t* bb = dir ? bb1 : bb0;
            float sl[8], hb[8];
#pragma unroll
            for (int e = 0; e < 8; ++e) { sl[e] = 0.f; hb[e] = 0.f; }
#pragma unroll 4
            for (int tt = 0; tt < CL; ++tt) { const int t = dir ? CL - 1 - tt : tt; const u32x4 lw = *(const u32x4*)(la + base + (size_t)t * D), bw = *(const u32x4*)(bb + base + (size_t)t * D);
                UNPK8(lw, lf); UNPK8(bw, bf_);
#pragma unroll
                for (int e = 0; e < 8; ++e) { hb[e] = fast_exp(lf[e]) * hb[e] + bf_[e]; sl[e] += lf[e]; } }
            f32x2* ap = agg + (size_t)(ck * 2 + dir) * D + ch;
#pragma unroll
            for (int e = 0; e < 8; e += 2) *(f32x4*)(ap + e) = (f32x4){fast_exp(sl[e]), hb[e], fast_exp(sl[e + 1]), hb[e + 1]};
        }
    }
}
__device__ __forceinline__ void lru_carry(const Ctx& c, const f32x2* agg, float* car) {
    const int n = 5 * 2 * D;
    for (int i = c.bid * NTHR + c.tid; i < n; i += c.nblk * NTHR) {
        const int ch = i % D, dir = (i / D) & 1, sq = i / (2 * D);
        const int ck0 = sq == 0 ? 0 : (TP + (sq - 1) * LS) / CL, nck = sq == 0 ? TP / CL : LS / CL;
        float h = 0.f;
        for (int k0 = 0; k0 < nck; k0 += 16) {
            f32x2 ab[16];
#pragma unroll
            for (int k = 0; k < 16; ++k) { const int kk = dir ? nck - 1 - (k0 + k) : k0 + k; ab[k] = agg[(size_t)((ck0 + kk) * 2 + dir) * D + ch]; }
#pragma unroll
            for (int k = 0; k < 16; ++k) { const int kk = dir ? nck - 1 - (k0 + k) : k0 + k; car[(size_t)((ck0 + kk) * 2 + dir) * D + ch] = h; h = ab[k].x * h + ab[k].y; }
        }
    }
}
__device__ __forceinline__ void lru_scan2(const Ctx& c, const bf16_t* la0, const bf16_t* bb0, const bf16_t* la1, bf16_t* bb1, const float* car, bf16_t* gb) {
    const int n = NCH * (D / 8);
    for (int i = c.bid * NTHR + c.tid; i < n; i += c.nblk * NTHR) {
        const int ck = i / (D / 8), ch = (i % (D / 8)) * 8; const size_t base = (size_t)ck * CL * D + ch;
        float h[8];
        { const f32x4 c0 = *(const f32x4*)(car + (size_t)(ck * 2 + 1) * D + ch), c1 = *(const f32x4*)(car + (size_t)(ck * 2 + 1) * D + ch + 4);
          h[0] = c0[0]; h[1] = c0[1]; h[2] = c0[2]; h[3] = c0[3]; h[4] = c1[0]; h[5] = c1[1]; h[6] = c1[2]; h[7] = c1[3]; }
#pragma unroll 4
        for (int t = CL - 1; t >= 0; --t) { const size_t o = base + (size_t)t * D; const u32x4 lw = *(const u32x4*)(la1 + o), bw = *(const u32x4*)(bb1 + o);
            UNPK8(lw, lf); UNPK8(bw, bf_);
#pragma unroll
            for (int e = 0; e < 8; ++e) h[e] = fast_exp(lf[e]) * h[e] + bf_[e];
            u32x4 w; w.x = cvt_pk_bf16(h[0], h[1]); w.y = cvt_pk_bf16(h[2], h[3]); w.z = cvt_pk_bf16(h[4], h[5]); w.w = cvt_pk_bf16(h[6], h[7]); *(u32x4*)(bb1 + o) = w; }
        { const f32x4 c0 = *(const f32x4*)(car + (size_t)(ck * 2 + 0) * D + ch), c1 = *(const f32x4*)(car + (size_t)(ck * 2 + 0) * D + ch + 4);
          h[0] = c0[0]; h[1] = c0[1]; h[2] = c0[2]; h[3] = c0[3]; h[4] = c1[0]; h[5] = c1[1]; h[6] = c1[2]; h[7] = c1[3]; }
#pragma unroll 4
        for (int t = 0; t < CL; ++t) { const size_t o = base + (size_t)t * D; const u32x4 lw = *(const u32x4*)(la0 + o), bw = *(const u32x4*)(bb0 + o), rw = *(const u32x4*)(bb1 + o), gw_ = *(const u32x4*)(gb + o);
            UNPK8(lw, lf); UNPK8(bw, bf_); UNPK8(rw, rf); UNPK8(gw_, gf);
#pragma unroll
            for (int e = 0; e < 8; ++e) h[e] = fast_exp(lf[e]) * h[e] + bf_[e];
            u32x4 w; w.x = cvt_pk_bf16(gf[0] * (h[0] + rf[0]), gf[1] * (h[1] + rf[1])); w.y = cvt_pk_bf16(gf[2] * (h[2] + rf[2]), gf[3] * (h[3] + rf[3]));
            w.z = cvt_pk_bf16(gf[4] * (h[4] + rf[4]), gf[5] * (h[5] + rf[5])); w.w = cvt_pk_bf16(gf[6] * (h[6] + rf[6]), gf[7] * (h[7] + rf[7])); *(u32x4*)(gb + o) = w; }
    }
}
#undef UNPK8
__device__ __forceinline__ void final_norm(const Ctx& c, const bf16_t* hbf, float* out, const float* rss, const float* g) {
    const size_t n4 = (size_t)T * D / 4;
    for (size_t i = (size_t)c.bid * NTHR + c.tid; i < n4; i += (size_t)c.nblk * NTHR) {
        const int row = (int)(i / (D / 4)), c4 = (int)(i % (D / 4)) * 4; const float rs = pg8::rstd_of(rss, row);
        const u32x2 w = *(const u32x2*)(hbf + i * 4); const f32x4 gv = *(const f32x4*)(g + c4);
        f32x4 v = (f32x4){bflo(w.x), bfhi(w.x), bflo(w.y), bfhi(w.y)}; v = v * rs * gv; *(f32x4*)(out + i * 4) = v;
    }
}

__device__ __forceinline__ const float* ldptr(volatile LAS unsigned* tab, int k) {
    unsigned lo = tab[2 * k], hi = tab[2 * k + 1]; lo = __builtin_amdgcn_readfirstlane(lo); hi = __builtin_amdgcn_readfirstlane(hi);
    return (const float*)(const __attribute__((address_space(1))) float*)(((unsigned long long)hi << 32) | (unsigned long long)lo);
}
#define IN(k) ldptr(tab, (k))
#define WGU1 ((bf16_t*)(ws + WS_WGU1))
#define WD1 ((bf16_t*)(ws + WS_WD1))
#define WGU2 ((bf16_t*)(ws + WS_WGU2))
#define WD2 ((bf16_t*)(ws + WS_WD2))
#define WPG ((bf16_t*)(ws + WS_WPG))
#define WPP ((bf16_t*)(ws + WS_WPP))
#define WMI ((bf16_t*)(ws + WS_WMI))
#define WMO ((bf16_t*)(ws + WS_WMO))
#define WLG ((bf16_t*)(ws + WS_WLG))
#define LSP ((float*)(ws + WS_SMALL))
#define RSS ((float*)(ws + WS_RSS2))
#define AGG ((f32x2*)(ws + WS_AGG))
#define S1 ((bf16_t*)(ws + WS_S1))
#define M1 ((bf16_t*)(ws + WS_M1))
#define M2 ((bf16_t*)(ws + WS_M2))
#define M3 ((bf16_t*)(ws + WS_M3))
#define PBF ((bf16_t*)out + (size_t)T * D)
#define RS ((bf16_t*)out)
#define RSSI(k) (RSS + (size_t)((k) & 1) * T * 16)
#define EPSET(k, v) do { const unsigned long long v_ = (unsigned long long)(v); eptab[2 * (k)] = (unsigned)v_; eptab[2 * (k) + 1] = (unsigned)(v_ >> 32); } while (0)
#define EPBEGIN __syncthreads(); if (c.tid == 0) {
#define EPEND } __syncthreads();
#define GEMM(EpiT, Aptr, Bptr, N_, K_, lda_, ldb_, agrp_) pg8::gemm_phase<EpiT, K_, lda_, ldb_, N_, agrp_>(c.lds, Aptr, Bptr, G, bid, c.tid, (step == 2 || step == 10) ? 1 : 0)

constexpr int NSTEP = 14;
__device__ __forceinline__ void table_init(const Params& P, unsigned char* lds_raw) {
    volatile LAS unsigned* tab0 = (volatile LAS unsigned*)((LAS unsigned char*)lds_raw + TAB_OFF);
    if (threadIdx.x == 0) {
#pragma unroll
        for (int k = 0; k < 48; ++k) { const unsigned long long v = (unsigned long long)P.in[k]; tab0[2 * k] = (unsigned)v; tab0[2 * k + 1] = (unsigned)(v >> 32); }
        { const unsigned long long v = (unsigned long long)P.out; tab0[96] = (unsigned)v; tab0[97] = (unsigned)(v >> 32); }
        { const unsigned long long v = (unsigned long long)P.ws; tab0[98] = (unsigned)v; tab0[99] = (unsigned)(v >> 32); }
    }
    __syncthreads();
}
template <int STEP>
__device__ __forceinline__ void run_step(int step_rt, int layer, unsigned char* lds_raw, bool& did, bool& sync) {
    {
        const int step = STEP >= 0 ? STEP : step_rt, kind = layer % 3, j = layer / 3;
        int tid_ = threadIdx.x, bid = blockIdx.x, G = gridDim.x; LAS unsigned char* lds_ = (LAS unsigned char*)lds_raw;
        asm volatile("" : "+v"(tid_)); asm volatile("" : "+s"(bid)); asm volatile("" : "+s"(G)); asm volatile("" : "+s"(lds_));
        Ctx c; c.tid = tid_; c.lane = c.tid & 63; c.wave = __builtin_amdgcn_readfirstlane(c.tid >> 6); c.bid = bid; c.nblk = G; c.lds = lds_;
        volatile LAS unsigned* tab = (volatile LAS unsigned*)(c.lds + TAB_OFF);
        volatile LAS unsigned* eptab = (volatile LAS unsigned*)(c.lds + TAB_OFF + 1024);
        unsigned char* ws = (unsigned char*)ldptr(tab, 49); float* out = (float*)ldptr(tab, 48);
        bool did = true, sync = true;
        switch (step) {
        case 0: {
            const size_t fo = (size_t)layer * D * DFF;
            convT(c, IN(5) + fo, D, DFF, DFF, IN(4) + layer * D, WGU1, D, 128, 256, 0);
            convT(c, IN(6) + fo, D, DFF, DFF, IN(4) + layer * D, WGU1, D, 128, 256, 128);
            convT(c, IN(7) + fo, DFF, D, D, nullptr, WD1, DFF, D, 0, 0);
            convT(c, IN(10) + fo, D, DFF, DFF, IN(9) + layer * D, WGU2, D, 128, 256, 0);
            convT(c, IN(11) + fo, D, DFF, DFF, IN(9) + layer * D, WGU2, D, 128, 256, 128);
            convT(c, IN(12) + fo, DFF, D, D, nullptr, WD2, DFF, D, 0, 0);
            convT(c, IN(14) + (size_t)layer * D * D, D, D, D, IN(13) + layer * D, WPG, D, D, 0, 0);
            convT(c, IN(15) + (size_t)layer * PLE * D, PLE, D, D, nullptr, WPP, PLE, D, 0, 0);
            const float* lnm = IN(8) + layer * D;
            const float* wi = kind == 0 ? IN(17) + (size_t)j * D * 3 * D : (kind == 1 ? IN(32) : IN(37));
            const float* wo = kind == 0 ? IN(30) + (size_t)j * D * D : (kind == 1 ? IN(35) : IN(46));
            const int ni = kind == 2 ? 2 * D : 3 * D;
            convT(c, wi, D, ni, ni, lnm, WMI, D, ni, 0, 0);
            convT(c, wo, D, D, D, nullptr, WMO, D, D, 0, 0);
            if (kind == 0) { const float* wo_ = IN(28) + (size_t)j * 64 * 2048; for (int i = bid * NTHR + c.tid; i < 64 * 2048; i += G * NTHR) ((bf16_t*)LSP)[i] = f2bf(wo_[(i & 63) * 2048 + (i >> 6)]); }
            if (kind == 2) {
                for (int dg = 0; dg < 16; ++dg)
                    convT(c, IN((dg & 1) ? 41 : 43) + (size_t)(dg >> 1) * 65536, 256, 256, 256, nullptr, WLG + (size_t)(dg >> 1) * 512 * 256, 256, 128, 256, (dg & 1) * 128);
                for (int i = bid * NTHR + c.tid; i < 2 * D; i += G * NTHR) { const float lam = IN(45)[i]; LSP[i] = -8.0f * 0.69314718056f * __builtin_amdgcn_logf(1.0f + fast_exp(-lam)); } }
            if (layer == 0) x_to_bf16(c, IN(0), IN(1), M2, RSSI(0));
        } break;
        case 1: case 10: {
            EPBEGIN EPSET(0, S1); EPSET(1, RSSI(4 * layer + (step == 1 ? 0 : 2))); EPEND
            GEMM(pg8::EpiSwiGLU, (step == 1 ? M2 : RS), (step == 1 ? WGU1 : WGU2), 2 * DFF, D, D, D, false);
            if (step == 1) {
                const int rem = (T / 256) * (2 * DFF / 256) % G;
                if (rem == 0 || bid >= rem) { Ctx c2 = c; c2.bid = rem == 0 ? bid : bid - rem; c2.nblk = rem == 0 ? G : G - rem;
                    p_to_bf16(c2, IN(2) + (size_t)layer * TP * PLE, IN(3) + (size_t)layer * TS * PLE, PBF); } }
        } break;
        case 2: case 9: case 11: {
            const float* mb = step != 9 ? nullptr : (kind == 0 ? IN(31) + j * D : (kind == 1 ? IN(36) : IN(47)));
            const float scale = step == 9 ? 1.0f : 0.5f;
            EPBEGIN EPSET(1, 0); EPSET(2, mb); EPSET(3, (step == 2 ? M2 : RS)); EPSET(5, RS); EPSET(6, RSSI(4 * layer + (step == 2 ? 1 : (step == 9 ? 2 : 3)))); EPSET(7, 0); EPSET(8, __float_as_uint(scale)); EPEND
            if (step == 9) { const bf16_t* A = kind == 0 ? S1 : (kind == 1 ? M1 : M2); GEMM(pg8::EpiResid<0>, A, WMO, D, D, D, D, false); }
            else GEMM(pg8::EpiResid<0>, S1, (step == 2 ? WD1 : WD2), D, DFF, DFF, DFF, false);
            sync = step != 11;
        } break;
        case 3: {
            const float* bias = kind == 0 ? IN(18) + (size_t)j * 3 * D : (kind == 1 ? IN(33) : IN(38));
            EPBEGIN EPSET(0, S1); EPSET(1, RSSI(4 * layer + 1)); EPSET(2, bias); EPSET(3, kind == 2 ? 2 * D : 3 * D); EPEND
            if (kind == 2) GEMM(pg8::EpiProj, RS, WMI, 2 * D, D, D, D, false); else GEMM(pg8::EpiProj, RS, WMI, 3 * D, D, D, D, false);
        } break;
        case 12: {
            EPBEGIN EPSET(0, M1); EPSET(1, 0); EPSET(2, 0); EPSET(3, D); EPEND
            GEMM(pg8::EpiProj, PBF, WPP, D, PLE, PLE, PLE, false);
        } break;
        case 4: {
            if (kind == 0) hy_elem(c, S1, IN(19) + (size_t)j * 9 * D, IN(20) + (size_t)j * 3 * D, M1, M2, M3);
            else if (kind == 1) na_attn(c, S1, IN(34), M1);
            else lru_elem(c, S1, IN(39), IN(40), M1, M2);
        } break;
        case 5: {
            if (kind == 0) {
                bf16_t* FK = S1 + (size_t)T * D;
                for (int hl = 0; hl < 2; ++hl)
                    hy_filter(c, hl ? LS : TP, hl ? (size_t)D * 2 * TP : (size_t)0, IN(21) + j * 33 * 64, IN(22) + j * 64, IN(23) + j * 4096, IN(24) + j * 64, IN(25) + j * 4096, IN(26) + j * 64, IN(27) + j * 64, (const bf16_t*)LSP, IN(29) + j * D, FK);
            } else if (kind == 2) {
                EPBEGIN EPSET(0, M1); EPSET(1, S1); EPSET(2, S1 + 2 * (size_t)T * D); EPSET(3, S1 + (size_t)T * D); EPSET(4, M3); EPSET(5, IN(44)); EPSET(6, IN(42)); EPSET(7, LSP); EPEND
                GEMM(pg8::EpiLruGates, M1, WLG, 4096, 256, D, 256, true);
            } else did = false;
        } break;
        case 6: {
            if (kind == 0) hy_longconv(c, M3, S1 + (size_t)T * D, S1 + 2 * (size_t)T * D);
            else if (kind == 2) lru_scan1(c, S1, S1 + (size_t)T * D, S1 + 2 * (size_t)T * D, M3, AGG);
            else did = false;
        } break;
        case 7: { if (kind == 2) lru_carry(c, AGG, (float*)(ws + WS_CAR)); else if (kind == 0) hy_final(c, S1 + 2 * (size_t)T * D, M1, M2, IN(29) + j * D, S1); else did = false; } break;
        case 8: { if (kind == 2) lru_scan2(c, S1, S1 + (size_t)T * D, S1 + 2 * (size_t)T * D, M3, (const float*)(ws + WS_CAR), M2); else did = false; } break;
        default: {
            EPBEGIN EPSET(1, RSSI(4 * layer + 3)); EPSET(2, 0); EPSET(3, RS); EPSET(5, M2); EPSET(6, RSSI(4 * layer + 4)); EPSET(7, M1); EPSET(8, 0); EPEND
            GEMM(pg8::EpiResid<1>, RS, WPG, D, D, D, D, false);
        } break;
        }
    }
}
template <int STEP>
__global__ void __launch_bounds__(NTHR, 2) step_kernel(Params P, int layer) {
    extern __shared__ __attribute__((aligned(16))) unsigned char lds_raw[];
    table_init(P, lds_raw);
    bool did = true, sync = true;
    run_step<STEP>(STEP, layer, lds_raw, did, sync);
}
__global__ void __launch_bounds__(NTHR, 2) final_kernel(Params P) {
    Ctx c; c.tid = threadIdx.x; c.lane = c.tid & 63; c.wave = __builtin_amdgcn_readfirstlane(c.tid >> 6); c.bid = blockIdx.x; c.nblk = gridDim.x; c.lds = nullptr;
    final_norm(c, (const bf16_t*)(P.ws + WS_M2), P.out, (const float*)(P.ws + WS_RSS2), P.in[16]);
}
__global__ void __launch_bounds__(NTHR, 2) trunk_fwd(Params P) {
    extern __shared__ __attribute__((aligned(16))) unsigned char lds_raw[];
    cg::grid_group grid = cg::this_grid();
    {   volatile LAS unsigned* st0 = (volatile LAS unsigned*)((LAS unsigned char*)lds_raw + TAB_OFF + 2048);
        if (threadIdx.x == 0) { st0[0] = 0u; st0[1] = 0u; (void)xb_add(&((unsigned*)(P.ws + WS_BAR))[XB_XCNT(xb_xcc_id())], 1u); } }
    table_init(P, lds_raw);
#pragma nounroll
    for (int ph = 0; ph < 4 * NSTEP; ++ph) {
        bool did = true, sync = true;
        run_step<-1>(ph % NSTEP, ph / NSTEP, lds_raw, did, sync);
#if PROBE
        {   const int st_ = ph % NSTEP; bool rep = false;
            if ((PROBE & 1) && (st_ == 1 || st_ == 10)) rep = true;
            if ((PROBE & 2) && st_ == 6 && (ph / NSTEP) % 3 == 0) rep = true;
            if ((PROBE & 8) && st_ == 0) rep = true;
            if ((PROBE & 16) && st_ == 3) rep = true;
            if ((PROBE & 32) && (st_ == 4 || st_ == 5) ) rep = true;
            { const int kd_ = (ph / NSTEP) % 3;
              if ((PROBE & 64) && st_ == 4 && kd_ == 0) rep = true;
              if ((PROBE & 128) && st_ == 5 && kd_ == 0) rep = true;
              if ((PROBE & 256) && st_ == 4 && kd_ == 1) rep = true;
              if ((PROBE & 512) && st_ == 4 && kd_ == 2) rep = true;
              if ((PROBE & 1024) && st_ == 5 && kd_ == 2) rep = true;
              if ((PROBE & 2048) && st_ == 6 && kd_ == 2) rep = true;
              if ((PROBE & 4096) && st_ == 7 && kd_ == 0) rep = true; }
            if (rep) { if (did && sync) xcd_barrier((unsigned*)(P.ws + WS_BAR), (volatile LAS unsigned*)((LAS unsigned char*)lds_raw + TAB_OFF + 2048)); run_step<-1>(ph % NSTEP, ph / NSTEP, lds_raw, did, sync); }
            if ((PROBE & 4) && did && sync) xcd_barrier((unsigned*)(P.ws + WS_BAR), (volatile LAS unsigned*)((LAS unsigned char*)lds_raw + TAB_OFF + 2048)); }
#endif
        if (did && sync) {
            if (ph == 0) grid.sync();
            else xcd_barrier((unsigned*)(P.ws + WS_BAR), (volatile LAS unsigned*)((LAS unsigned char*)lds_raw + TAB_OFF + 2048));
        }
    }
    {   Ctx c; c.tid = threadIdx.x; c.lane = c.tid & 63; c.wave = __builtin_amdgcn_readfirstlane(c.tid >> 6); c.bid = blockIdx.x; c.nblk = gridDim.x; c.lds = (LAS unsigned char*)lds_raw;
        final_norm(c, (const bf16_t*)(P.ws + WS_M2), P.out, (const float*)(P.ws + WS_RSS2), P.in[16]); }
}

#ifndef MEGA
#define MEGA 1
#endif
template <int STEP> static void launch_step(const Params& p, int layer, int grid, hipStream_t stream) {
    static bool attr = false;
    if (!attr) { (void)hipFuncSetAttribute((const void*)step_kernel<STEP>, hipFuncAttributeMaxDynamicSharedMemorySize, LDS_BYTES); attr = true; }
    hipLaunchKernelGGL(step_kernel<STEP>, dim3(grid), dim3(NTHR), LDS_BYTES, stream, p, layer);
}
extern "C" void kernel_launch(void* const* d_in, const int* in_sizes, int n_in, void* d_out, int out_size, void* d_ws, size_t ws_size, hipStream_t stream) {
    static int grid = 0;
    if (grid == 0) {
        if (n_in != 48 || out_size != T * D || ws_size < WS_END) { fprintf(stderr, "kernel_launch: unexpected shapes n_in %d out %d ws %zu (need %zu)\n", n_in, out_size, ws_size, (size_t)WS_END); grid = -1; return; }
        int dev = 0, cus = 0;
        (void)hipGetDevice(&dev); (void)hipDeviceGetAttribute(&cus, hipDeviceAttributeMultiprocessorCount, dev);
        if (hipFuncSetAttribute((const void*)trunk_fwd, hipFuncAttributeMaxDynamicSharedMemorySize, LDS_BYTES) != hipSuccess) { fprintf(stderr, "kernel_launch: hipFuncSetAttribute failed\n"); grid = -1; return; }
        (void)hipGetLastError();
        grid = cus;
    }
    if (grid < 0) return;
    Params p{};
    for (int i = 0; i < 48; ++i) p.in[i] = (const float*)d_in[i];
    p.out = (float*)d_out; p.ws = (unsigned char*)d_ws;
#if MEGA
    (void)hipMemsetAsync((unsigned char*)d_ws + WS_BAR, 0, XCD_BAR_WORDS * 4, stream);
    void* args[] = {&p};
    hipError_t e = hipLaunchCooperativeKernel((const void*)trunk_fwd, dim3(grid), dim3(NTHR), args, LDS_BYTES, stream);
    if (e != hipSuccess) fprintf(stderr, "cooperative launch failed: %s (grid %d)\n", hipGetErrorString(e), grid);
#else
    for (int layer = 0; layer < 4; ++layer) {
        const int kind = layer % 3;
        launch_step<0>(p, layer, grid, stream); launch_step<1>(p, layer, grid, stream); launch_step<2>(p, layer, grid, stream); launch_step<3>(p, layer, grid, stream);
        launch_step<4>(p, layer, grid, stream);
        if (kind != 1) { launch_step<5>(p, layer, grid, stream); launch_step<6>(p, layer, grid, stream); }
        if (kind != 1) launch_step<7>(p, layer, grid, stream);
        if (kind == 2) launch_step<8>(p, layer, grid, stream);
        launch_step<9>(p, layer, grid, stream); launch_step<10>(p, layer, grid, stream); launch_step<11>(p, layer, grid, stream); launch_step<12>(p, layer, grid, stream); launch_step<13>(p, layer, grid, stream);
    }
    hipLaunchKernelGGL(final_kernel, dim3(grid), dim3(NTHR), 0, stream, p);
#endif
}
```

```cpp
#include <hip/hip_runtime.h>
#include <hip/hip_cooperative_groups.h>
#include <cstdio>
namespace cg = cooperative_groups;

#define LAS __attribute__((address_space(3)))
typedef unsigned short bf16_t;
typedef short bf16x8 __attribute__((ext_vector_type(8)));
typedef float f32x4 __attribute__((ext_vector_type(4)));
typedef float f32x2 __attribute__((ext_vector_type(2)));
typedef float f32x16 __attribute__((ext_vector_type(16)));
typedef unsigned u32x4 __attribute__((ext_vector_type(4)));
typedef unsigned u32x2 __attribute__((ext_vector_type(2)));

#ifndef PROBE
#define PROBE 0
#endif
constexpr int D = 1024, DFF = 2816, TP = 16384, TS = 32768, T = TP + TS, LS = 8192, PLE = 256;
constexpr int NTHR = 512;
constexpr float EPS = 1e-6f;
constexpr size_t MiB = 1u << 20;
constexpr size_t UB = (size_t)T * D * 2;
constexpr size_t WS_WGU1 = 0, WS_WD1 = 11 * MiB, WS_WGU2 = WS_WD1 + 11 * MiB / 2, WS_WD2 = WS_WGU2 + 11 * MiB, WS_WPG = 33 * MiB, WS_WPP = 35 * MiB,
                 WS_WMI = WS_WPP + MiB / 2, WS_WMO = WS_WMI + 6 * MiB, WS_WLG = WS_WMO + 2 * MiB, WS_SMALL = WS_WLG + 2 * MiB, WS_RSS = 46 * MiB,
                 WS_AGG = 50 * MiB, WS_S1 = 62 * MiB, WS_M1 = WS_S1 + 3 * UB, WS_M2 = WS_M1 + UB, WS_M3 = WS_M2 + UB, WS_RSS2 = WS_M3 + UB, WS_BAR = WS_RSS2 + 7 * MiB, WS_CAR = WS_RSS2 + 8 * MiB, WS_END = WS_CAR + 6 * MiB;
constexpr int TAB_OFF = 143360, LDS_BYTES = 147456;

struct Params { const float* in[48]; float* out; unsigned char* ws; };

__device__ __forceinline__ unsigned cvt_pk_bf16(float lo, float hi) { unsigned r; asm volatile("v_cvt_pk_bf16_f32 %0, %1, %2" : "=v"(r) : "v"(lo), "v"(hi)); return r; }
__device__ __forceinline__ float bflo(unsigned w) { return __uint_as_float(w << 16); }
__device__ __forceinline__ float bfhi(unsigned w) { return __uint_as_float(w & 0xffff0000u); }
__device__ __forceinline__ float bf2f(bf16_t b) { return __uint_as_float(((unsigned)b) << 16); }
__device__ __forceinline__ bf16_t f2bf(float f) { return (bf16_t)(cvt_pk_bf16(f, 0.f) & 0xffffu); }
__device__ __forceinline__ float fast_sigmoid(float x) { return __builtin_amdgcn_rcpf(1.0f + __builtin_amdgcn_exp2f(-1.44269504089f * x)); }
__device__ __forceinline__ float fast_exp(float x) { return __builtin_amdgcn_exp2f(1.44269504089f * x); }
__device__ __forceinline__ float hw_sin(float x) { return __builtin_amdgcn_sinf(x * 0.15915494309189535f); }
__device__ __forceinline__ float hw_cos(float x) { return __builtin_amdgcn_cosf(x * 0.15915494309189535f); }
__device__ __forceinline__ float fast_tanh(float y) { return 1.0f - 2.0f * __builtin_amdgcn_rcpf(1.0f + __builtin_amdgcn_exp2f(2.88539008178f * y)); }

namespace pg8 {
constexpr int BM = 256, BK = 64, HALF = 128, HTB = HALF * BK * 2, STAGE_BYTES = 8 * HTB, NXCD = 8, WGM = 8;
__host__ __device__ __forceinline__ int lds_byte(int r, int c) { const int st = (r >> 4) * 2 + (c >> 5), rr = r & 15, cc = c & 31, ob = rr * 64 + cc * 2; return st * 1024 + (ob ^ (((ob >> 9) & 1) << 5)); }
__host__ __device__ __forceinline__ void stage_rc(int b, int& R, int& C) { const int st = b / 1024, sb = b % 1024, swz = sb ^ (((sb >> 9) & 1) << 5); R = (st >> 1) * 16 + swz / 64; C = (st & 1) * 32 + (swz % 64) / 2; }
__host__ __device__ __forceinline__ int perm32(int rho) { const int n = rho >> 4, i = rho & 15; return 8 * (i >> 2) + 4 * n + (i & 3); }

struct Unit { int pm, pn; };
struct Gemm { const bf16_t* A; const bf16_t* Bt; int M, N, K, lda, ldb, agrp; };

struct StaticOrder {
    int nM, nN, nwg, G, c, rev;
    __host__ __device__ void init(int M, int N, int G_, int c_) { nM = M / BM; nN = N / BM; nwg = nM * nN; G = G_; c = c_; rev = 0; }
    __host__ __device__ bool next(int i, Unit& u) const {
        const int L = i * G + c; if (L >= nwg) return false;
        int wgid = L; { const int q = nwg / NXCD, r = nwg % NXCD, xcd = wgid % NXCD, off = wgid / NXCD; wgid = (xcd < r ? xcd * (q + 1) : r * (q + 1) + (xcd - r) * q) + off; }
        const int nig = WGM * nN, gid = wgid / nig, fm = gid * WGM, gsz = (nM - fm) < WGM ? (nM - fm) : WGM;
        u.pm = fm + ((wgid % nig) % gsz); u.pn = (wgid % nig) / gsz; if (rev) u.pm = nM - 1 - u.pm; return true;
    }
};

template <class Epi, int KK, int LDA, int LDB, int NN, bool AGRP>
__device__ __forceinline__ void gemm_phase(LAS unsigned char* lds, const bf16_t* gA, const bf16_t* gBt, int G_, int bid_, int tid) {
    const Epi E{};
    struct { const bf16_t* A; const bf16_t* Bt; int lda, ldb, agrp; } g{gA, gBt, LDA, LDB, AGRP ? 1 : 0};
    StaticOrder S; S.init(49152, NN, G_, bid_); S.rev = (KK == 2816) ? 1 : 0;
    const int wid = __builtin_amdgcn_readfirstlane(tid >> 6), lane = tid & 63, wr = wid >> 2, wc = wid & 3, fr = lane & 15, fq = lane >> 4;
    constexpr int K = KK, nt = K / BK;
    unsigned voffA[2], voffB[2];
#pragma unroll
    for (int i = 0; i < 2; ++i) { int R, C; stage_rc(tid * 16 + i * 8192, R, C); const int Rb = Epi::PERM ? ((R & ~31) + perm32(R & 31)) : R;
        voffA[i] = (unsigned)(R * g.lda + C) * 2u; voffB[i] = (unsigned)(Rb * g.ldb + C) * 2u; }
    const size_t kstep = (size_t)(BK * 2);
    constexpr size_t hstepA = (size_t)HALF * LDA * 2, hstepB = (size_t)HALF * LDB * 2;
    constexpr size_t tstepA = 2 * hstepA, tstepB = 2 * hstepB;
    const unsigned ldsw = (unsigned)wid * 1024u;
    const int aoff = lds_byte(wr * 64 + fr, fq * 8), boff = lds_byte(wc * 32 + fr, fq * 8);
#define PG8_SA(b, h) (((b) * 2 + (h)) * HTB)
#define PG8_SB(b, h) ((4 + (b) * 2 + (h)) * HTB)
#define PG8_STAGE(bufoff, gbase, voff) do { _Pragma("unroll") for (int _i = 0; _i < 2; ++_i) \
        __builtin_amdgcn_global_load_lds((const unsigned*)((const char*)(gbase) + (voff)[_i]), (LAS unsigned*)(lds + (bufoff) + ldsw + _i * 8192), 16, 0, 0); } while (0)
#define PG8_LDA(dst, b, h) do { _Pragma("unroll") for (int m = 0; m < 4; ++m) _Pragma("unroll") for (int k = 0; k < 2; ++k) dst[m][k] = *(const LAS bf16x8*)(lds + PG8_SA(b, h) + aoff + m * 2048 + k * 1024); } while (0)
#define PG8_LDB(dst, b, h) do { _Pragma("unroll") for (int n = 0; n < 2; ++n) _Pragma("unroll") for (int k = 0; k < 2; ++k) dst[n][k] = *(const LAS bf16x8*)(lds + PG8_SB(b, h) + boff + n * 2048 + k * 1024); } while (0)
#define PG8_MMA(ai, bj, At, Bt) do { __builtin_amdgcn_s_setprio(1); _Pragma("unroll") for (int m = 0; m < 4; ++m) _Pragma("unroll") for (int n = 0; n < 2; ++n) _Pragma("unroll") for (int k = 0; k < 2; ++k) \
        acc[ai][bj][m][n] = __builtin_amdgcn_mfma_f32_16x16x32_bf16(Bt[n][k], At[m][k], acc[ai][bj][m][n], 0, 0, 0); __builtin_amdgcn_s_setprio(0); } while (0)
#define PG8_WAIT_V(n) asm volatile("s_waitcnt vmcnt(" #n ")" ::: "memory")
#define PG8_WAIT_L(n) asm volatile("s_waitcnt lgkmcnt(" #n ")" ::: "memory")
#define PG8_BAR __builtin_amdgcn_s_barrier()
#define PG8_SCHED __builtin_amdgcn_sched_barrier(0)
#define PG8_ACOL(pn) (AGRP ? (size_t)((((pn) >> 1) & 3) * 512) : (size_t)0)
    Unit cur, nxt; int ui = 0;
    if (!S.next(0, cur)) return;
    float zr = 0.f; asm volatile("" : "+v"(zr));
    f32x4 acc[2][2][4][2];
#pragma unroll
    for (int a = 0; a < 2; ++a)
#pragma unroll
        for (int b = 0; b < 2; ++b)
#pragma unroll
            for (int m = 0; m < 4; ++m)
#pragma unroll
                for (int n = 0; n < 2; ++n) acc[a][b][m][n] = (f32x4){zr, zr, zr, zr};
    bf16x8 At[4][2], B0[2][2], B1[2][2];
    const char* cA = (const char*)g.A + (size_t)cur.pm * tstepA + PG8_ACOL(cur.pn); const char* cB = (const char*)g.Bt + (size_t)cur.pn * tstepB;
    PG8_STAGE(PG8_SB(0, 0), cB, voffB); PG8_STAGE(PG8_SA(0, 0), cA, voffA); PG8_STAGE(PG8_SB(0, 1), cB + hstepB, voffB); PG8_STAGE(PG8_SA(0, 1), cA + hstepA, voffA);
    if (wr == 1) PG8_BAR;
    PG8_WAIT_V(4); PG8_BAR;
    PG8_STAGE(PG8_SB(1, 0), cB + kstep, voffB); PG8_STAGE(PG8_SA(1, 0), cA + kstep, voffA); PG8_STAGE(PG8_SB(1, 1), cB + hstepB + kstep, voffB);
    PG8_WAIT_V(6); PG8_BAR;
    for (;;) {
        const bool has_next = S.next(ui + 1, nxt);
        const char* nA = has_next ? (const char*)g.A + (size_t)nxt.pm * tstepA + PG8_ACOL(nxt.pn) : cA; const char* nB = has_next ? (const char*)g.Bt + (size_t)nxt.pn * tstepB : cB;
#pragma nounroll
        for (int t = 0; t < nt; t += 2) {
            const bool last = (t == nt - 2);
            const char* a1 = cA + (size_t)(t + 1) * kstep;
            const char* a2 = last ? nA : cA + (size_t)(t + 2) * kstep; const char* b2 = last ? nB : cB + (size_t)(t + 2) * kstep;
            const char* a3 = a2 + kstep; const char* b3 = b2 + kstep;
            PG8_LDB(B0, 0, 0); PG8_SCHED; PG8_LDA(At, 0, 0); PG8_STAGE(PG8_SA(1, 1), a1 + hstepA, voffA);
            PG8_WAIT_L(8); PG8_BAR; PG8_WAIT_L(0); PG8_MMA(0, 0, At, B0); PG8_BAR; PG8_SCHED;
            PG8_LDB(B1, 0, 1); PG8_STAGE(PG8_SB(0, 0), b2, voffB);
            PG8_BAR; PG8_WAIT_L(0); PG8_MMA(0, 1, At, B1); PG8_BAR;
            PG8_LDA(At, 0, 1); PG8_STAGE(PG8_SA(0, 0), a2, voffA);
            PG8_BAR; PG8_WAIT_L(0); PG8_MMA(1, 0, At, B0); PG8_BAR; PG8_SCHED;
            PG8_STAGE(PG8_SB(0, 1), b2 + hstepB, voffB);
            PG8_WAIT_V(6); PG8_BAR; PG8_MMA(1, 1, At, B1); PG8_BAR;
            PG8_LDB(B0, 1, 0); PG8_SCHED; PG8_LDA(At, 1, 0); PG8_STAGE(PG8_SA(0, 1), a2 + hstepA, voffA);
            PG8_WAIT_L(8); PG8_BAR; PG8_WAIT_L(0); PG8_MMA(0, 0, At, B0); PG8_BAR; PG8_SCHED;
            PG8_LDB(B1, 1, 1); PG8_STAGE(PG8_SB(1, 0), b3, voffB);
            PG8_BAR; PG8_WAIT_L(0); PG8_MMA(0, 1, At, B1); PG8_BAR;
            PG8_LDA(At, 1, 1); PG8_STAGE(PG8_SA(1, 0), a3, voffA);
            PG8_BAR; PG8_WAIT_L(0); PG8_MMA(1, 0, At, B0); PG8_BAR; PG8_SCHED;
            PG8_STAGE(PG8_SB(1, 1), b3 + hstepB, voffB);
            PG8_WAIT_V(6); PG8_BAR; PG8_MMA(1, 1, At, B1); PG8_BAR;
        }
        E(acc, cur, wr, wc, fr, fq, lds);
        if (!has_next) break;
#pragma unroll
        for (int a = 0; a < 2; ++a)
#pragma unroll
            for (int b = 0; b < 2; ++b)
#pragma unroll
                for (int m = 0; m < 4; ++m)
#pragma unroll
                    for (int n = 0; n < 2; ++n) acc[a][b][m][n] = (f32x4){zr, zr, zr, zr};
        cur = nxt; cA = nA; cB = nB; ++ui;
    }
    PG8_WAIT_V(0);
    if (wr == 0) PG8_BAR;
    PG8_BAR;
#undef PG8_SA
#undef PG8_SB
#undef PG8_STAGE
#undef PG8_LDA
#undef PG8_LDB
#undef PG8_MMA
#undef PG8_WAIT_V
#undef PG8_WAIT_L
#undef PG8_BAR
#undef PG8_SCHED
#undef PG8_ACOL
}

__device__ __forceinline__ float rstd_of(const float* rss, int row) {
    const f32x4* p = (const f32x4*)(rss + (size_t)row * 16); const f32x4 a = p[0], b = p[1], c = p[2], d = p[3];
    const float s = ((a[0] + a[1]) + (a[2] + a[3])) + ((b[0] + b[1]) + (b[2] + b[3])) + (((c[0] + c[1]) + (c[2] + c[3])) + ((d[0] + d[1]) + (d[2] + d[3])));
    return rsqrtf(s * (1.0f / 1024.0f) + EPS); }
__device__ __forceinline__ float rstd_of4(const float* rss, int row, int fq) {
    const f32x4 a = *(const f32x4*)(rss + (size_t)row * 16 + 4 * fq); float s = (a[0] + a[1]) + (a[2] + a[3]);
    s += __shfl_xor(s, 16); s += __shfl_xor(s, 32);
    return rsqrtf(s * (1.0f / 1024.0f) + EPS); }
__device__ __forceinline__ unsigned long long ep64(LAS unsigned char* lds, int k) {
    volatile LAS unsigned* t = (volatile LAS unsigned*)(lds + TAB_OFF + 1024); unsigned lo = t[2 * k], hi = t[2 * k + 1];
    lo = __builtin_amdgcn_readfirstlane(lo); hi = __builtin_amdgcn_readfirstlane(hi); return ((unsigned long long)hi << 32) | (unsigned long long)lo; }
#define EPP(T_, k) ((T_)(__attribute__((address_space(1))) char*)ep64(lds, (k)))

struct EpiSwiGLU {
    static constexpr bool PERM = true;
    __device__ __forceinline__ void operator()(const f32x4 (&acc)[2][2][4][2], const Unit& u, int wr, int wc, int fr, int fq, LAS unsigned char* lds) const {
        bf16_t* O = EPP(bf16_t*, 0); const float* rss = EPP(const float*, 1);
        const int row0 = u.pm * BM + wr * 64 + fr, j0 = u.pn * 128 + wc * 32 + 8 * fq;
#pragma unroll
        for (int ai = 0; ai < 2; ++ai)
#pragma unroll
            for (int m = 0; m < 4; ++m) { const int row = row0 + ai * HALF + m * 16; const float rs = rstd_of4(rss, row, fq);
                float h[8];
#pragma unroll
                for (int n = 0; n < 2; ++n)
#pragma unroll
                    for (int e = 0; e < 4; ++e) { const float gt = acc[ai][0][m][n][e] * rs, up = acc[ai][1][m][n][e] * rs; h[n * 4 + e] = gt * fast_sigmoid(gt) * up; }
                u32x4 w; w.x = cvt_pk_bf16(h[0], h[1]); w.y = cvt_pk_bf16(h[2], h[3]); w.z = cvt_pk_bf16(h[4], h[5]); w.w = cvt_pk_bf16(h[6], h[7]);
                *(u32x4*)(O + (size_t)row * DFF + j0) = w; }
    }
};
struct EpiProj {
    static constexpr bool PERM = true;
    __device__ __forceinline__ void operator()(const f32x4 (&acc)[2][2][4][2], const Unit& u, int wr, int wc, int fr, int fq, LAS unsigned char* lds) const {
        bf16_t* O = EPP(bf16_t*, 0); const float* rss = EPP(const float*, 1); const float* bias = EPP(const float*, 2); const int ldc = (int)ep64(lds, 3);
        const int row0 = u.pm * BM + wr * 64 + fr, col0 = u.pn * BM + wc * 32 + 8 * fq;
        f32x4 bv[2][2];
#pragma unroll
        for (int bj = 0; bj < 2; ++bj)
#pragma unroll
            for (int n = 0; n < 2; ++n) bv[bj][n] = bias ? *(const f32x4*)(bias + col0 + bj * HALF + 4 * n) : (f32x4){0.f, 0.f, 0.f, 0.f};
#pragma unroll
        for (int ai = 0; ai < 2; ++ai)
#pragma unroll
            for (int m = 0; m < 4; ++m) { const int row = row0 + ai * HALF + m * 16; const float rs = rss ? rstd_of4(rss, row, fq) : 1.0f;
#pragma unroll
                for (int bj = 0; bj < 2; ++bj) { const f32x4 v0 = acc[ai][bj][m][0] * rs + bv[bj][0], v1 = acc[ai][bj][m][1] * rs + bv[bj][1];
                    u32x4 w; w.x = cvt_pk_bf16(v0[0], v0[1]); w.y = cvt_pk_bf16(v0[2], v0[3]); w.z = cvt_pk_bf16(v1[0], v1[1]); w.w = cvt_pk_bf16(v1[2], v1[3]);
                    *(u32x4*)(O + (size_t)row * ldc + col0 + bj * HALF) = w; } }
    }
};
template <int MODE> struct EpiResid {
    static constexpr bool PERM = true;
    __device__ __forceinline__ void operator()(const f32x4 (&acc)[2][2][4][2], const Unit& u, int wr, int wc, int fr, int fq, LAS unsigned char* lds) const {
        const float* rss_in = EPP(const float*, 1); const float* bias = EPP(const float*, 2);
        const bf16_t* base = EPP(const bf16_t*, 3);
        bf16_t* hb = EPP(bf16_t*, 5); float* rss_out = EPP(float*, 6); const bf16_t* pp = EPP(const bf16_t*, 7); const float scale = __uint_as_float((unsigned)ep64(lds, 8));
        const int row0 = u.pm * BM + wr * 64 + fr, col0 = u.pn * BM + wc * 32 + 8 * fq;
        f32x4 bv[2][2];
#pragma unroll
        for (int bj = 0; bj < 2; ++bj)
#pragma unroll
            for (int n = 0; n < 2; ++n) bv[bj][n] = (MODE == 0 && bias) ? *(const f32x4*)(bias + col0 + bj * HALF + 4 * n) : (f32x4){0.f, 0.f, 0.f, 0.f};
#pragma unroll
        for (int ai = 0; ai < 2; ++ai)
#pragma unroll
            for (int m = 0; m < 4; ++m) { const int row = row0 + ai * HALF + m * 16; const size_t off = (size_t)row * D + col0;
                float rs = 1.0f; if (MODE == 1) rs = rstd_of4(rss_in, row, fq);
                float ss = 0.f;
#pragma unroll
                for (int bj = 0; bj < 2; ++bj) { const size_t o = off + bj * HALF; const u32x4 bw = *(const u32x4*)(base + o);
                    const float bs[8] = {bflo(bw.x), bfhi(bw.x), bflo(bw.y), bfhi(bw.y), bflo(bw.z), bfhi(bw.z), bflo(bw.w), bfhi(bw.w)};
                    float hn[8];
                    if (MODE == 0) {
#pragma unroll
                        for (int n = 0; n < 2; ++n)
#pragma unroll
                            for (int e = 0; e < 4; ++e) hn[4 * n + e] = bs[4 * n + e] + (acc[ai][bj][m][n][e] + bv[bj][n][e]) * scale;
                    } else { const u32x4 pw = *(const u32x4*)(pp + o);
                        const float pv[8] = {bflo(pw.x), bfhi(pw.x), bflo(pw.y), bfhi(pw.y), bflo(pw.z), bfhi(pw.z), bflo(pw.w), bfhi(pw.w)};
#pragma unroll
                        for (int n = 0; n < 2; ++n)
#pragma unroll
                            for (int e = 0; e < 4; ++e) hn[4 * n + e] = bs[4 * n + e] + fast_sigmoid(acc[ai][bj][m][n][e] * rs) * pv[4 * n + e]; }
                    u32x4 w; w.x = cvt_pk_bf16(hn[0], hn[1]); w.y = cvt_pk_bf16(hn[2], hn[3]); w.z = cvt_pk_bf16(hn[4], hn[5]); w.w = cvt_pk_bf16(hn[6], hn[7]); *(u32x4*)(hb + o) = w;
                    const float hr[8] = {bflo(w.x), bfhi(w.x), bflo(w.y), bfhi(w.y), bflo(w.z), bfhi(w.z), bflo(w.w), bfhi(w.w)};
                    ss += ((hr[0] * hr[0] + hr[1] * hr[1]) + (hr[2] * hr[2] + hr[3] * hr[3])) + ((hr[4] * hr[4] + hr[5] * hr[5]) + (hr[6] * hr[6] + hr[7] * hr[7])); }
                ss += __shfl_xor(ss, 16); ss += __shfl_xor(ss, 32);
                if (fq == 0) rss_out[(size_t)row * 16 + u.pn * 4 + wc] = ss; }
    }
};
struct EpiLruGates {
    static constexpr bool PERM = true;
    __device__ __forceinline__ void operator()(const f32x4 (&acc)[2][2][4][2], const Unit& u, int wr, int wc, int fr, int fq, LAS unsigned char* lds) const {
        const int grp = u.pn >> 1, d = grp >> 2, blk = grp & 3, c0 = blk * 256 + (u.pn & 1) * 128 + wc * 32 + 8 * fq;
        const int row0 = u.pm * BM + wr * 64 + fr;
        const bf16_t* xb = EPP(const bf16_t*, 0); bf16_t* LA = EPP(bf16_t*, 1 + d); bf16_t* BB = EPP(bf16_t*, 3 + d);
        const float* bx = EPP(const float*, 5); const float* ba = EPP(const float*, 6); const float* lsp = EPP(const float*, 7);
        f32x4 vbx[2], vba[2], vls[2];
#pragma unroll
        for (int n = 0; n < 2; ++n) { vbx[n] = *(const f32x4*)(bx + d * D + c0 + 4 * n); vba[n] = *(const f32x4*)(ba + d * D + c0 + 4 * n); vls[n] = *(const f32x4*)(lsp + d * D + c0 + 4 * n); }
#pragma unroll
        for (int ai = 0; ai < 2; ++ai)
#pragma unroll
            for (int m = 0; m < 4; ++m) { const int row = row0 + ai * HALF + m * 16; const size_t o = (size_t)row * D + c0;
                const bool first = d == 0 ? ((row & (LS - 1)) == 0 && row != LS) : ((row & (LS - 1)) == LS - 1 && row != LS - 1);
                const u32x4 xw = *(const u32x4*)(xb + o);
                const float xv[8] = {bflo(xw.x), bfhi(xw.x), bflo(xw.y), bfhi(xw.y), bflo(xw.z), bfhi(xw.z), bflo(xw.w), bfhi(xw.w)};
                float lo[8], bo[8];
#pragma unroll
                for (int n = 0; n < 2; ++n)
#pragma unroll
                    for (int e = 0; e < 4; ++e) { const int qd = 4 * n + e; const float gx = fast_sigmoid(acc[ai][0][m][n][e] + vbx[n][e]), ga = fast_sigmoid(acc[ai][1][m][n][e] + vba[n][e]);
                        const float l = ga * vls[n][e]; const float mult = first ? 1.0f : __builtin_amdgcn_sqrtf(fmaxf(1.0f - fast_exp(2.0f * l), 0.f)); lo[qd] = l; bo[qd] = mult * gx * xv[qd]; }
                u32x4 w; w.x = cvt_pk_bf16(lo[0], lo[1]); w.y = cvt_pk_bf16(lo[2], lo[3]); w.z = cvt_pk_bf16(lo[4], lo[5]); w.w = cvt_pk_bf16(lo[6], lo[7]); *(u32x4*)(LA + o) = w;
                w.x = cvt_pk_bf16(bo[0], bo[1]); w.y = cvt_pk_bf16(bo[2], bo[3]); w.z = cvt_pk_bf16(bo[4], bo[5]); w.w = cvt_pk_bf16(bo[6], bo[7]); *(u32x4*)(BB + o) = w; }
    }
};
#undef EPP
}


#define XB_TMO      128
#define XB_XCNT(j)  (256  + 64 * (j))
#define XB_XSUB(j)  (1280 + 64 * (j))
#define XB_XGEN(j)  (2304 + 64 * (j))
#define XB_TOP      3328
#define XB_TOPGEN   3392
#define XCD_BAR_WORDS 3456
#define XB_SPIN_CAP (1u << 22)
__device__ __forceinline__ unsigned xb_ld(unsigned* p)              { return __hip_atomic_load(p, __ATOMIC_RELAXED, __HIP_MEMORY_SCOPE_AGENT); }
__device__ __forceinline__ unsigned xb_add(unsigned* p, unsigned v) { return __hip_atomic_fetch_add(p, v, __ATOMIC_RELAXED, __HIP_MEMORY_SCOPE_AGENT); }
__device__ __forceinline__ unsigned xb_xcc_id() { return (unsigned)__builtin_amdgcn_s_getreg((3 << 11) | 20) & 0xFu; }
#define XB_SPIN(cond, bar) do { unsigned _sp = 0; while (cond) { __builtin_amdgcn_s_sleep(1); \
    if ((++_sp & 255u) == 0u) { if (xb_ld(&(bar)[XB_TMO])) break; if (_sp > XB_SPIN_CAP) { atomicAdd(&(bar)[XB_TMO], 1u); break; } } } } while (0)
__device__ __forceinline__ void xcd_barrier_complete(unsigned* bar, unsigned x, unsigned& nloc, unsigned& nx) {
    const unsigned G = gridDim.x * gridDim.y * gridDim.z;
    unsigned sum, cnt, mine, sp = 0u;
    for (;;) {
        sum = 0u; cnt = 0u; mine = 0u;
#pragma unroll
        for (unsigned j = 0; j < 16; ++j) { const unsigned c = xb_ld(&bar[XB_XCNT(j)]); sum += c; cnt += (c > 0u) ? 1u : 0u; mine = (j == x) ? c : mine; }
        if (sum == G) break;
        __builtin_amdgcn_s_sleep(1);
        if ((++sp & 255u) == 0u) { if (xb_ld(&bar[XB_TMO])) break; if (sp > XB_SPIN_CAP) { atomicAdd(&bar[XB_TMO], 1u); break; } }
    }
    nloc = mine > 0u ? mine : 1u; nx = cnt > 0u ? cnt : 1u;
}
__device__ __forceinline__ void xcd_barrier(unsigned* bar, volatile LAS unsigned* st) {
    asm volatile("s_waitcnt vmcnt(0)" ::: "memory");
    __syncthreads();
    if (threadIdx.x == 0) {
        const unsigned x = xb_xcc_id();
        __builtin_amdgcn_s_waitcnt(0);
        unsigned nloc = st[0], nx = st[1];
        if (nloc == 0u) { xcd_barrier_complete(bar, x, nloc, nx); st[0] = nloc; st[1] = nx; }
        const unsigned old = xb_add(&bar[XB_XSUB(x)], 1u);
        const unsigned gen = old / nloc;
        if (old + 1u == (gen + 1u) * nloc) {
            __builtin_amdgcn_fence(__ATOMIC_RELEASE, "agent");
            asm volatile("s_waitcnt vmcnt(0)" ::: "memory");
            const unsigned og = xb_add(&bar[XB_TOP], 1u);
            const unsigned tg = og / nx;
            if (og + 1u == (tg + 1u) * nx) xb_add(&bar[XB_TOPGEN], 1u);
            else XB_SPIN(xb_ld(&bar[XB_TOPGEN]) == tg, bar);
            __builtin_amdgcn_fence(__ATOMIC_ACQUIRE, "agent");
            xb_add(&bar[XB_XGEN(x)], 1u);
            asm volatile("s_waitcnt vmcnt(0)" ::: "memory");
        } else {
            XB_SPIN(xb_ld(&bar[XB_XGEN(x)]) == gen, bar);
            __builtin_amdgcn_fence(__ATOMIC_ACQUIRE, "agent");
            asm volatile("s_waitcnt vmcnt(0)" ::: "memory");
        }
    }
    __syncthreads();
}

struct Ctx { int tid, lane, wave, bid, nblk; LAS unsigned char* lds; };

__device__ __forceinline__ void convT(const Ctx& c, const float* W, int K, int N, int ldw, const float* gain, bf16_t* dst, int ldd, int G, int S, int off) {
    LAS float* tile = (LAS float*)c.lds;
    const int nk = K / 64, nn = N / 256, njobs = nk * nn;
    for (int job = c.bid; job < njobs; job += c.nblk) {
        const int kt = job / nn, ntile = job % nn, k0 = kt * 64, n0 = ntile * 256;
        f32x4 v[8];
#pragma unroll
        for (int i = 0; i < 8; ++i) { const int e = c.tid + i * NTHR, kk = e >> 6, n4 = (e & 63) * 4; v[i] = *(const f32x4*)(W + (size_t)(k0 + kk) * ldw + n0 + n4); if (gain) v[i] = v[i] * gain[k0 + kk]; }
        __syncthreads();
#pragma unroll
        for (int i = 0; i < 8; ++i) { const int e = c.tid + i * NTHR, kk = e >> 6, n4 = (e & 63) * 4; LAS float* tp = tile + kk * 257 + n4; tp[0] = v[i][0]; tp[1] = v[i][1]; tp[2] = v[i][2]; tp[3] = v[i][3]; }
        __syncthreads();
#pragma unroll
        for (int i = 0; i < 4; ++i) { const int e = c.tid + i * NTHR, n = e & 255, ks = (e >> 8) * 8;
            float x[8];
#pragma unroll
            for (int j = 0; j < 8; ++j) x[j] = tile[(ks + j) * 257 + n];
            u32x4 w; w.x = cvt_pk_bf16(x[0], x[1]); w.y = cvt_pk_bf16(x[2], x[3]); w.z = cvt_pk_bf16(x[4], x[5]); w.w = cvt_pk_bf16(x[6], x[7]);
            const int ng = n0 + n, drow = (ng / G) * S + (ng % G) + off;
            *(u32x4*)(dst + (size_t)drow * ldd + k0 + ks) = w; }
    }
    __syncthreads();
}

__device__ __forceinline__ void x_to_bf16(const Ctx& c, const float* xp, const float* xs, bf16_t* hb, float* rss) {
    const int gw = c.bid * 8 + c.wave, nw = c.nblk * 8;
    for (int row0 = gw * 2; row0 < T; row0 += nw * 2) {
        f32x4 v[2][4];
#pragma unroll
        for (int rr = 0; rr < 2; ++rr) { const int row = row0 + rr; const float* src = row < TP ? xp + (size_t)row * D : xs + (size_t)(row - TP) * D;
#pragma unroll
            for (int i = 0; i < 4; ++i) v[rr][i] = *(const f32x4*)(src + i * 256 + c.lane * 4); }
#pragma unroll
        for (int rr = 0; rr < 2; ++rr) { const int row = row0 + rr; float ss = 0.f;
#pragma unroll
            for (int i = 0; i < 4; ++i) { u32x2 w; w.x = cvt_pk_bf16(v[rr][i][0], v[rr][i][1]); w.y = cvt_pk_bf16(v[rr][i][2], v[rr][i][3]); *(u32x2*)(hb + (size_t)row * D + i * 256 + c.lane * 4) = w;
                const float a0 = bflo(w.x), a1 = bfhi(w.x), a2 = bflo(w.y), a3 = bfhi(w.y); ss += (a0 * a0 + a1 * a1) + (a2 * a2 + a3 * a3); }
#pragma unroll
            for (int o = 32; o >= 1; o >>= 1) ss += __shfl_xor(ss, o);
            if (c.lane < 16) rss[(size_t)row * 16 + c.lane] = c.lane == 0 ? ss : 0.f; }
    }
}
__device__ __forceinline__ void p_to_bf16(const Ctx& c, const float* pp_, const float* ps_, bf16_t* dst) {
    const size_t n8 = (size_t)T * PLE / 8, np8 = (size_t)TP * PLE / 8, stride = (size_t)c.nblk * NTHR;
    for (size_t i0 = (size_t)c.bid * NTHR + c.tid; i0 < n8; i0 += 4 * stride) {
        f32x4 a[4], b[4];
#pragma unroll
        for (int k = 0; k < 4; ++k) { const size_t i = i0 + k * stride; if (i < n8) { const float* src = i < np8 ? pp_ + i * 8 : ps_ + (i - np8) * 8; a[k] = *(const f32x4*)src; b[k] = *(const f32x4*)(src + 4); } }
#pragma unroll
        for (int k = 0; k < 4; ++k) { const size_t i = i0 + k * stride; if (i < n8) {
            u32x4 w; w.x = cvt_pk_bf16(a[k][0], a[k][1]); w.y = cvt_pk_bf16(a[k][2], a[k][3]); w.z = cvt_pk_bf16(b[k][0], b[k][1]); w.w = cvt_pk_bf16(b[k][2], b[k][3]);
            *(u32x4*)(dst + i * 8) = w; } }
    }
}
__device__ __forceinline__ void zero_f32(const Ctx& c, float* p, size_t n) {
    for (size_t i = ((size_t)c.bid * NTHR + c.tid) * 4; i < n; i += (size_t)c.nblk * NTHR * 4) *(f32x4*)(p + i) = (f32x4){0.f, 0.f, 0.f, 0.f};
}
__device__ __forceinline__ void seq_of(int row, int& s0, int& L) { if (row < TP) { s0 = 0; L = TP; } else { s0 = TP + ((row - TP) & ~(LS - 1)); L = LS; } }

__device__ __forceinline__ void hy_elem(const Ctx& c, const bf16_t* u, const float* cw, const float* cb, bf16_t* vv, bf16_t* x0c, bf16_t* vvT) {
    LAS bf16_t* tile = (LAS bf16_t*)c.lds;
    const int tr = c.tid >> 3, cg = c.tid & 7;
    for (int job = c.bid; job < (T / 256) * 16; job += c.nblk) {
        const int c0 = (job & 15) * 64, ch = c0 + cg * 8, rowj = (job >> 4) * 256;
        float wgt[3][3][8], bia[3][8];
#pragma unroll
        for (int part = 0; part < 3; ++part) { const int col = part * D + ch;
#pragma unroll
            for (int h2 = 0; h2 < 2; ++h2) { const f32x4 b4 = *(const f32x4*)(cb + col + 4 * h2);
#pragma unroll
                for (int e = 0; e < 4; ++e) bia[part][4 * h2 + e] = b4[e];
#pragma unroll
                for (int tap = 0; tap < 3; ++tap) { const f32x4 w4 = *(const f32x4*)(cw + tap * 3072 + col + 4 * h2);
#pragma unroll
                    for (int e = 0; e < 4; ++e) wgt[part][tap][4 * h2 + e] = w4[e]; } } }
        for (int tl = 0; tl < 4; ++tl) {
            const int row0 = rowj + tl * 64, row = row0 + tr;
            int s0, L; seq_of(row, s0, L); const bool hasp = row > s0, hasn = row < s0 + L - 1;
            float r[3][8];
#pragma unroll
            for (int part = 0; part < 3; ++part) { const int col = part * D + ch; const bf16_t* p = u + (size_t)row * 3072 + col;
                const u32x4 z4 = (u32x4){0u, 0u, 0u, 0u};
                const u32x4 wc_ = *(const u32x4*)p, wp = hasp ? *(const u32x4*)(p - 3072) : z4, wn = hasn ? *(const u32x4*)(p + 3072) : z4;
                const unsigned wcv[4] = {wc_.x, wc_.y, wc_.z, wc_.w}, wpv[4] = {wp.x, wp.y, wp.z, wp.w}, wnv[4] = {wn.x, wn.y, wn.z, wn.w};
#pragma unroll
                for (int e = 0; e < 4; ++e) {
                    r[part][2 * e] = bia[part][2 * e] + wgt[part][0][2 * e] * bflo(wpv[e]) + wgt[part][1][2 * e] * bflo(wcv[e]) + wgt[part][2][2 * e] * bflo(wnv[e]);
                    r[part][2 * e + 1] = bia[part][2 * e + 1] + wgt[part][0][2 * e + 1] * bfhi(wpv[e]) + wgt[part][1][2 * e + 1] * bfhi(wcv[e]) + wgt[part][2][2 * e + 1] * bfhi(wnv[e]); } }
            u32x4 w; w.x = cvt_pk_bf16(r[0][0], r[0][1]); w.y = cvt_pk_bf16(r[0][2], r[0][3]); w.z = cvt_pk_bf16(r[0][4], r[0][5]); w.w = cvt_pk_bf16(r[0][6], r[0][7]);
            *(u32x4*)(x0c + (size_t)row * D + ch) = w;
            w.x = cvt_pk_bf16(r[2][0] * r[1][0], r[2][1] * r[1][1]); w.y = cvt_pk_bf16(r[2][2] * r[1][2], r[2][3] * r[1][3]);
            w.z = cvt_pk_bf16(r[2][4] * r[1][4], r[2][5] * r[1][5]); w.w = cvt_pk_bf16(r[2][6] * r[1][6], r[2][7] * r[1][7]);
                __syncthreads();
            { const unsigned wv[4] = {w.x, w.y, w.z, w.w};
#pragma unroll
              for (int e = 0; e < 4; ++e) { tile[(cg * 8 + 2 * e) * 74 + tr] = (bf16_t)(wv[e] & 0xffffu); tile[(cg * 8 + 2 * e + 1) * 74 + tr] = (bf16_t)(wv[e] >> 16); } }
            __syncthreads();
            { const int cc = c.tid >> 3, tg = c.tid & 7; const LAS unsigned* tp = (const LAS unsigned*)(tile + cc * 74 + tg * 8); u32x4 v; v.x = tp[0]; v.y = tp[1]; v.z = tp[2]; v.w = tp[3];
              *(u32x4*)(vvT + (size_t)(c0 + cc) * T + row0 + tg * 8) = v; }
        }
    }
    __syncthreads();
}
__device__ __forceinline__ void hy_final(const Ctx& c, const bf16_t* yT, const bf16_t* vv, const bf16_t* x0c, const float* skip, bf16_t* yg) {
    LAS bf16_t* tile = (LAS bf16_t*)c.lds;
    for (int job = c.bid; job < (T / 64) * 16; job += c.nblk) {
        const int row0 = (job >> 4) * 64, c0 = (job & 15) * 64;
        __syncthreads();
        { const int cc = c.tid >> 3, tg = c.tid & 7; const u32x4 v = *(const u32x4*)(yT + (size_t)(c0 + cc) * T + row0 + tg * 8); const unsigned wv[4] = {v.x, v.y, v.z, v.w};
#pragma unroll
          for (int e = 0; e < 4; ++e) { tile[(tg * 8 + 2 * e) * 74 + cc] = (bf16_t)(wv[e] & 0xffffu); tile[(tg * 8 + 2 * e + 1) * 74 + cc] = (bf16_t)(wv[e] >> 16); } }
        __syncthreads();
        const int tr = c.tid >> 3, cg = c.tid & 7, row = row0 + tr, ch = c0 + cg * 8; const size_t o = (size_t)row * D + ch;
        const LAS unsigned* tp = (const LAS unsigned*)(tile + tr * 74 + cg * 8); u32x4 yv; yv.x = tp[0]; yv.y = tp[1]; yv.z = tp[2]; yv.w = tp[3];
        const u32x4 xw = *(const u32x4*)(x0c + o);
        u32x4 w;
        w.x = cvt_pk_bf16(bflo(yv.x) * bflo(xw.x), bfhi(yv.x) * bfhi(xw.x));
        w.y = cvt_pk_bf16(bflo(yv.y) * bflo(xw.y), bfhi(yv.y) * bfhi(xw.y));
        w.z = cvt_pk_bf16(bflo(yv.z) * bflo(xw.z), bfhi(yv.z) * bfhi(xw.z));
        w.w = cvt_pk_bf16(bflo(yv.w) * bflo(xw.w), bfhi(yv.w) * bfhi(xw.w));
        *(u32x4*)(yg + o) = w;
    }
    __syncthreads();
}
__device__ __forceinline__ void hy_filter(const Ctx& c, int L, size_t kbase, const float* w1, const float* b1, const float* w2, const float* b2, const float* w3, const float* b3,
                                          const float* freq, const bf16_t* woutB, const float* skip, bf16_t* FK) {
    const int lane = c.lane, wave = c.wave, r = lane & 31, h = lane >> 5;
    LAS bf16_t* h3b = (LAS bf16_t*)c.lds;
    LAS float* wl1 = (LAS float*)(c.lds + 8192); LAS float* wl2 = wl1 + 33 * 64; LAS float* wl3 = wl2 + 64 * 64;
    __syncthreads();
    for (int i = c.tid; i < 33 * 64; i += NTHR) wl1[i] = w1[i];
    for (int i = c.tid; i < 64 * 64; i += NTHR) { wl2[i] = w2[i]; wl3[i] = w3[i]; }
    __syncthreads();
    const float fr = freq[lane], vb1 = b1[lane], vb2 = b2[lane], vb3 = b3[lane];
    const float dmin = -3.0701134573253945f, dmax = -15.350567286626972f;
    for (int job = c.bid; job < L / 32; job += c.nblk) {
        const int tb = job * 32, t0 = tb + wave * 4;
        float z[4];
#pragma unroll
        for (int tt = 0; tt < 4; ++tt) { const int t = t0 + tt; float v = 0.f;
            if (lane == 0) v = (float)t / (float)(L - 1);
            else if (lane <= 32) { const int bi = (lane - 1) & 15; const float fb = 1e-4f + (float)bi * ((15.0f - 1e-4f) / 15.0f); const float ang = (6.283185307179586f / (float)L) * (float)t; const float a = fb * ang;
                v = lane <= 16 ? hw_cos(a) : -hw_sin(a); }
            z[tt] = v; }
        float hh[4], a[4];
#pragma unroll
        for (int tt = 0; tt < 4; ++tt) a[tt] = vb1;
        for (int i = 0; i < 33; ++i) { const float w = wl1[i * 64 + lane];
#pragma unroll
            for (int tt = 0; tt < 4; ++tt) a[tt] += __shfl(z[tt], i) * w; }
#pragma unroll
        for (int tt = 0; tt < 4; ++tt) { hh[tt] = hw_sin(fr * a[tt]); a[tt] = vb2; }
        for (int i = 0; i < 64; ++i) { const float w = wl2[i * 64 + lane];
#pragma unroll
            for (int tt = 0; tt < 4; ++tt) a[tt] += __shfl(hh[tt], i) * w; }
#pragma unroll
        for (int tt = 0; tt < 4; ++tt) { hh[tt] = hw_sin(fr * a[tt]); a[tt] = vb3; }
        for (int i = 0; i < 64; ++i) { const float w = wl3[i * 64 + lane];
#pragma unroll
            for (int tt = 0; tt < 4; ++tt) a[tt] += __shfl(hh[tt], i) * w; }
        __syncthreads();
#pragma unroll
        for (int tt = 0; tt < 4; ++tt) h3b[(wave * 4 + tt) * 72 + lane] = f2bf(hw_sin(fr * a[tt]));
        __syncthreads();
        bf16x8 Bf[4];
#pragma unroll
        for (int s = 0; s < 4; ++s) Bf[s] = *(const LAS bf16x8*)(h3b + r * 72 + 16 * s + 8 * h);
        const int t = tb + r; const float tn = (float)t / (float)(L - 1);
        for (int nt = 0; nt < 8; ++nt) {
            const int n0 = wave * 256 + nt * 32;
            bf16x8 Af[4];
#pragma unroll
            for (int s = 0; s < 4; ++s) Af[s] = *(const bf16x8*)(woutB + (size_t)(n0 + r) * 64 + 16 * s + 8 * h);
            f32x16 acc;
#pragma unroll
            for (int i = 0; i < 16; ++i) acc[i] = 0.f;
#pragma unroll
            for (int s = 0; s < 4; ++s) acc = __builtin_amdgcn_mfma_f32_32x32x16_bf16(Af[s], Bf[s], acc, 0, 0, 0);
            const int dir = n0 >> 10;
#pragma unroll
            for (int i = 0; i < 16; ++i) { const int n = n0 + (i & 3) + 8 * (i >> 2) + 4 * h, ch = n & 1023;
                const float delta = fabsf(dmin + (float)ch * ((dmax - dmin) / 1023.0f));
                const bool zero = (dir == 1 && t == 0); const int idx = dir == 0 ? L - t : (zero ? 0 : L + t);
                FK[kbase + (size_t)ch * 2 * L + idx] = zero ? (bf16_t)0 : f2bf(acc[i] * fast_exp(-tn * delta) + ((dir == 0 && t == 0) ? skip[ch] : 0.f)); }
        }
    }
    __syncthreads();
}
template <int RHO> __device__ __forceinline__ u32x4 kr_shift(const u32x4 lo, const u32x4 hi) {
    const unsigned d[8] = {lo.x, lo.y, lo.z, lo.w, hi.x, hi.y, hi.z, hi.w};
    u32x4 o; unsigned ov[4];
#pragma unroll
    for (int k = 0; k < 4; ++k) {
        if (RHO % 2 == 0) ov[k] = d[4 - RHO / 2 + k];
        else ov[k] = __builtin_amdgcn_alignbit(d[4 - (RHO - 1) / 2 + k], d[3 - (RHO - 1) / 2 + k], 16);
    }
    o.x = ov[0]; o.y = ov[1]; o.z = ov[2]; o.w = ov[3]; return o;
}
template <bool PROMPT>
__device__ __forceinline__ void longconv_item(const Ctx& c, int ch, const bf16_t* vvT, const bf16_t* KR, bf16_t* yT) {
    constexpr int L = PROMPT ? TP : LS, NB = L / 256, NSEQ = PROMPT ? 1 : 4, VLEN = L + 768;
    constexpr int KB_OFF = NSEQ * VLEN * 2, KB_BYTES = (2 * L + (2 * L / 256) * 8) * 2, RB_OFF = KB_OFF + KB_BYTES;
    constexpr int NSTEPS = (L + 256) / 16, KSPLIT = PROMPT ? 8 : 4, PER = NSTEPS / KSPLIT;
    static_assert(RB_OFF + 32768 <= TAB_OFF && NSTEPS % KSPLIT == 0 && PER % 2 == 0, "long-conv LDS map");
    LAS unsigned char* lds = c.lds;
    const bf16_t* kr = KR + (PROMPT ? (size_t)ch * (2 * TP) : (size_t)D * (2 * TP) + (size_t)ch * (2 * LS));
    const size_t tok0 = (size_t)ch * T + (PROMPT ? 0 : TP);
    const int lane = c.lane, wave = c.wave, r = lane & 31, h = lane >> 5;
    __syncthreads();
#pragma unroll
    for (int s = 0; s < NSEQ; ++s) {
        for (int i = c.tid; i < 96; i += NTHR) { const int idx = i < 32 ? i * 8 : 256 + L + (i - 32) * 8; *(LAS u32x4*)(lds + (s * VLEN + idx) * 2) = (u32x4){0u, 0u, 0u, 0u}; }
        for (int i = c.tid; i < L / 8; i += NTHR) *(LAS u32x4*)(lds + (s * VLEN + 256 + i * 8) * 2) = *(const u32x4*)(vvT + tok0 + (size_t)s * L + i * 8);
    }
    constexpr int NG = 2 * L / 8 / NTHR;
    u32x4 klo[NG], khi[NG];
#pragma unroll
    for (int k = 0; k < NG; ++k) { const int X0 = (c.tid + NTHR * k) * 8; khi[k] = *(const u32x4*)(kr + X0); klo[k] = (u32x4){0u, 0u, 0u, 0u}; if (X0 >= 8) klo[k] = *(const u32x4*)(kr + X0 - 8); }
#define KR_STAGE(R) _Pragma("unroll") for (int k = 0; k < NG; ++k) { const int X0 = (c.tid + NTHR * k) * 8; *(LAS u32x4*)(lds + KB_OFF + (X0 + (X0 >> 8) * 8) * 2) = kr_shift<R>(klo[k], khi[k]); }
    float yst[4]; unsigned ywd[4];
    for (int rho = 0; rho < 8; ++rho) {
        __syncthreads();
        switch (rho) { case 0: { KR_STAGE(0) } break; case 1: { KR_STAGE(1) } break; case 2: { KR_STAGE(2) } break; case 3: { KR_STAGE(3) } break;
                       case 4: { KR_STAGE(4) } break; case 5: { KR_STAGE(5) } break; case 6: { KR_STAGE(6) } break; default: { KR_STAGE(7) } break; }
        __syncthreads();
        f32x16 acc0, acc1;
#pragma unroll
        for (int i = 0; i < 16; ++i) { acc0[i] = 0.f; acc1[i] = 0.f; }
        const int q = PROMPT ? wave : (wave & 3), p = PROMPT ? 0 : (wave >> 2);
        if (PROMPT) {
            const int bb = (8 * r + 8 * h) * 2, ab0 = KB_OFF + (264 * (NB - r - 1) + 8 * h) * 2, ab1 = KB_OFF + (264 * (NB - 32 - r - 1) + 8 * h) * 2;
#define LC_LD(X, Y, Z, ST) { const int kp_ = 16 * (ST), ao_ = 2 * (kp_ + 8 * (kp_ >> 8)), bo_ = 2 * kp_; X = *(const LAS bf16x8*)(lds + bb + bo_); Y = *(const LAS bf16x8*)(lds + ab0 + ao_); Z = *(const LAS bf16x8*)(lds + ab1 + ao_); }
            const int st0 = q * PER, st1 = st0 + PER;
            bf16x8 Ba, A0a, A1a, Bb, A0b, A1b;
            LC_LD(Ba, A0a, A1a, st0);
            for (int st = st0; st < st1; st += 2) {
                LC_LD(Bb, A0b, A1b, st + 1);
                acc0 = __builtin_amdgcn_mfma_f32_32x32x16_bf16(A0a, Ba, acc0, 0, 0, 0); acc1 = __builtin_amdgcn_mfma_f32_32x32x16_bf16(A1a, Ba, acc1, 0, 0, 0);
                { const int sn = st + 2 < st1 ? st + 2 : st1 - 1; LC_LD(Ba, A0a, A1a, sn); }
                acc0 = __builtin_amdgcn_mfma_f32_32x32x16_bf16(A0b, Bb, acc0, 0, 0, 0); acc1 = __builtin_amdgcn_mfma_f32_32x32x16_bf16(A1b, Bb, acc1, 0, 0, 0);
            }
#undef LC_LD
        } else {
            const int ab = KB_OFF + (264 * (NB - r - 1) + 8 * h) * 2, bb0 = ((2 * p) * VLEN + 8 * r + 8 * h) * 2, bb1 = ((2 * p + 1) * VLEN + 8 * r + 8 * h) * 2;
#define LC_LD(X, Y, Z, ST) { const int kp_ = 16 * (ST), ao_ = 2 * (kp_ + 8 * (kp_ >> 8)), bo_ = 2 * kp_; X = *(const LAS bf16x8*)(lds + ab + ao_); Y = *(const LAS bf16x8*)(lds + bb0 + bo_); Z = *(const LAS bf16x8*)(lds + bb1 + bo_); }
            const int st0 = q * PER, st1 = st0 + PER;
            bf16x8 Aa, B0a, B1a, Ab, B0b, B1b;
            LC_LD(Aa, B0a, B1a, st0);
            for (int st = st0; st < st1; st += 2) {
                LC_LD(Ab, B0b, B1b, st + 1);
                acc0 = __builtin_amdgcn_mfma_f32_32x32x16_bf16(Aa, B0a, acc0, 0, 0, 0); acc1 = __builtin_amdgcn_mfma_f32_32x32x16_bf16(Aa, B1a, acc1, 0, 0, 0);
                { const int sn = st + 2 < st1 ? st + 2 : st1 - 1; LC_LD(Aa, B0a, B1a, sn); }
                acc0 = __builtin_amdgcn_mfma_f32_32x32x16_bf16(Ab, B0b, acc0, 0, 0, 0); acc1 = __builtin_amdgcn_mfma_f32_32x32x16_bf16(Ab, B1b, acc1, 0, 0, 0);
            }
#undef LC_LD
        }
        LAS float* rb = (LAS float*)(lds + RB_OFF);
#pragma unroll
        for (int j = 0; j < 2; ++j) {
#pragma unroll
            for (int i = 0; i < 16; ++i) rb[wave * 1024 + i * 64 + lane] = j == 0 ? acc0[i] : acc1[i];
            __syncthreads();
            if (PROMPT) {
#pragma unroll
                for (int k2 = 0; k2 < 2; ++k2) { const int e = c.tid + NTHR * k2, v = j * 2 + k2; float s = 0.f;
#pragma unroll
                    for (int w = 0; w < 8; ++w) s += rb[w * 1024 + e];
                    if ((rho & 1) == 0) yst[v] = s;
                    else { const unsigned pw = cvt_pk_bf16(yst[v], s);
                        if ((rho & 2) == 0) ywd[v] = pw;
                        else { const int i = e >> 6, l = e & 63, m = (i & 3) + 8 * (i >> 2) + 4 * (l >> 5), n = l & 31, t0 = 256 * (32 * j + m) + 8 * n + (rho & 4);
                            *(u32x2*)((char*)yT + ((unsigned)tok0 + (unsigned)t0) * 2u) = (u32x2){ywd[v], pw}; } } }
            } else {
#pragma unroll
                for (int k2 = 0; k2 < 4; ++k2) { const int idx = c.tid + NTHR * k2, pp = idx >> 10, e = idx & 1023; float s = 0.f;
#pragma unroll
                    for (int w = 0; w < 4; ++w) s += rb[(pp * 4 + w) * 1024 + e];
                    const int i = e >> 6, l = e & 63, m = (i & 3) + 8 * (i >> 2) + 4 * (l >> 5), n = l & 31, t = 256 * m + 8 * n + rho;
                    yT[tok0 + (size_t)(2 * pp + j) * L + t] = f2bf(s); }
            }
            __syncthreads();
        }
    }
}
#undef KR_STAGE
__device__ __forceinline__ void longconv_sample2(const Ctx& c, int ch, const bf16_t* vvT, const bf16_t* KR, bf16_t* yT) {
    constexpr int L = LS, NB = L / 256, NSEQ = 4, VLEN = L + 768;
    constexpr int KB_OFF = NSEQ * VLEN * 2, KB_BYTES = (2 * L + (2 * L / 256) * 8) * 2;
    constexpr int NSTEPS = (L + 256) / 16, PER = NSTEPS / 4;
    static_assert(KB_OFF + 2 * KB_BYTES <= TAB_OFF && KB_BYTES >= 32768 && NSTEPS % 4 == 0 && PER % 2 == 0, "long-conv LDS map (sample)");
    LAS unsigned char* lds = c.lds;
    const bf16_t* kr = KR + (size_t)D * (2 * TP) + (size_t)ch * (2 * LS);
    const size_t tok0 = (size_t)ch * T + TP;
    const int lane = c.lane, wave = c.wave, r = lane & 31, h = lane >> 5;
    __syncthreads();
#pragma unroll
    for (int s = 0; s < NSEQ; ++s) {
        for (int i = c.tid; i < 96; i += NTHR) { const int idx = i < 32 ? i * 8 : 256 + L + (i - 32) * 8; *(LAS u32x4*)(lds + (s * VLEN + idx) * 2) = (u32x4){0u, 0u, 0u, 0u}; }
        for (int i = c.tid; i < L / 8; i += NTHR) *(LAS u32x4*)(lds + (s * VLEN + 256 + i * 8) * 2) = *(const u32x4*)(vvT + tok0 + (size_t)s * L + i * 8);
    }
    constexpr int NG = 2 * L / 8 / NTHR;
    u32x4 klo[NG], khi[NG];
#pragma unroll
    for (int k = 0; k < NG; ++k) { const int X0 = (c.tid + NTHR * k) * 8; khi[k] = *(const u32x4*)(kr + X0); klo[k] = (u32x4){0u, 0u, 0u, 0u}; if (X0 >= 8) klo[k] = *(const u32x4*)(kr + X0 - 8); }
    float yst[8]; unsigned ywd[8];
#define KR_STAGE2(R) _Pragma("unroll") for (int k = 0; k < NG; ++k) { const int X0 = (c.tid + NTHR * k) * 8, P_ = (X0 + (X0 >> 8) * 8) * 2; \
        *(LAS u32x4*)(lds + KB_OFF + P_) = kr_shift<R>(klo[k], khi[k]); *(LAS u32x4*)(lds + KB_OFF + KB_BYTES + P_) = kr_shift<R + 1>(klo[k], khi[k]); }
    for (int rp = 0; rp < 4; ++rp) {
        __syncthreads();
        switch (rp) { case 0: { KR_STAGE2(0) } break; case 1: { KR_STAGE2(2) } break; case 2: { KR_STAGE2(4) } break; default: { KR_STAGE2(6) } break; }
        __syncthreads();
        f32x16 acc00, acc01, acc10, acc11;
#pragma unroll
        for (int i = 0; i < 16; ++i) { acc00[i] = 0.f; acc01[i] = 0.f; acc10[i] = 0.f; acc11[i] = 0.f; }
        const int q = wave & 3, p = wave >> 2;
        const int aba = KB_OFF + (264 * (NB - r - 1) + 8 * h) * 2, abb = aba + KB_BYTES, bb0 = ((2 * p) * VLEN + 8 * r + 8 * h) * 2, bb1 = ((2 * p + 1) * VLEN + 8 * r + 8 * h) * 2;
#define LC_LD(W, X, Y, Z, ST) { const int kp_ = 16 * (ST), ao_ = 2 * (kp_ + 8 * (kp_ >> 8)), bo_ = 2 * kp_; W = *(const LAS bf16x8*)(lds + aba + ao_); X = *(const LAS bf16x8*)(lds + abb + ao_); \
            Y = *(const LAS bf16x8*)(lds + bb0 + bo_); Z = *(const LAS bf16x8*)(lds + bb1 + bo_); }
#define LC_MM(W, X, Y, Z) { acc00 = __builtin_amdgcn_mfma_f32_32x32x16_bf16(W, Y, acc00, 0, 0, 0); acc01 = __builtin_amdgcn_mfma_f32_32x32x16_bf16(W, Z, acc01, 0, 0, 0); \
            acc10 = __builtin_amdgcn_mfma_f32_32x32x16_bf16(X, Y, acc10, 0, 0, 0); acc11 = __builtin_amdgcn_mfma_f32_32x32x16_bf16(X, Z, acc11, 0, 0, 0); }
        const int st0 = q * PER, st1 = st0 + PER;
        bf16x8 Aa0, Ab0, B00, B10, Aa1, Ab1, B01, B11;
        LC_LD(Aa0, Ab0, B00, B10, st0);
        for (int st = st0; st < st1; st += 2) {
            LC_LD(Aa1, Ab1, B01, B11, st + 1);
            LC_MM(Aa0, Ab0, B00, B10);
            { const int sn = st + 2 < st1 ? st + 2 : st1 - 1; LC_LD(Aa0, Ab0, B00, B10, sn); }
            LC_MM(Aa1, Ab1, B01, B11);
        }
#undef LC_LD
#undef LC_MM
        __syncthreads();
        LAS float* rb = (LAS float*)(lds + KB_OFF);
        static_assert(2 * KB_BYTES >= 65536, "reduce buffer must fit in the two filter copies");
#pragma unroll
        for (int rr = 0; rr < 2; ++rr) {
            if (rr) __syncthreads();
#pragma unroll
            for (int i = 0; i < 16; ++i) { rb[wave * 2048 + i * 64 + lane] = rr == 0 ? acc00[i] : acc10[i]; rb[wave * 2048 + 1024 + i * 64 + lane] = rr == 0 ? acc01[i] : acc11[i]; }
            __syncthreads();
#pragma unroll
            for (int k2 = 0; k2 < 4; ++k2)
#pragma unroll
                for (int sb = 0; sb < 2; ++sb) { const int idx = c.tid + NTHR * k2, pp = idx >> 10, e = idx & 1023, v = k2 * 2 + sb; float s = 0.f;
#pragma unroll
                    for (int w = 0; w < 4; ++w) s += rb[(pp * 4 + w) * 2048 + sb * 1024 + e];
                    if (rr == 0) yst[v] = s;
                    else { const unsigned pw = cvt_pk_bf16(yst[v], s);
                        if ((rp & 1) == 0) ywd[v] = pw;
                        else { const int i = e >> 6, l = e & 63, m = (i & 3) + 8 * (i >> 2) + 4 * (l >> 5), n = l & 31, t0 = 256 * m + 8 * n + 2 * (rp & 2);
                            *(u32x2*)((char*)yT + ((unsigned)tok0 + (unsigned)((2 * pp + sb) * L + t0)) * 2u) = (u32x2){ywd[v], pw}; } } }
        }
    }
#undef KR_STAGE2
}
__device__ __forceinline__ void hy_longconv(const Ctx& c, const bf16_t* vvT, const bf16_t* KR, bf16_t* yT) {
    for (int item = c.bid; item < 2 * D; item += c.nblk) {
        if (item < D) longconv_item<true>(c, item, vvT, KR, yT); else longconv_sample2(c, item - D, vvT, KR, yT);
    }
    __syncthreads();
}

__device__ __forceinline__ float dpp_xor1(float x) { return __int_as_float(__builtin_amdgcn_update_dpp(0, __float_as_int(x), 0xB1, 0xF, 0xF, true)); }
__device__ __forceinline__ float dpp_xor2(float x) { return __int_as_float(__builtin_amdgcn_update_dpp(0, __float_as_int(x), 0x4E, 0xF, 0xF, true)); }
__device__ __forceinline__ void na_attn(const Ctx& c, const bf16_t* qkv, const float* rpb, bf16_t* o) {
    LAS unsigned char* KV = c.lds;
    LAS bf16_t* VT = (LAS bf16_t*)(c.lds + 40960);
    constexpr int VP = 52, VH = 32 * VP + 8;
    LAS float* rp = (LAS float*)(c.lds + 40960 + 16 * VH * 2);
    int hh_loaded = -1;
    const int ql = c.lane & 31, h = c.lane >> 5;
    const bool xmap = false; const int nsteps = (3072 + c.nblk - 1) / c.nblk;
    for (int stp = 0; stp < nsteps; ++stp) {
        int hh, ch2, grow;
        if (xmap) { const int x = c.bid & 7, lb = c.bid >> 3; grow = 96 * x + 8 * stp + (lb >> 2); hh = (lb >> 1) & 1; ch2 = lb & 1; }
        else { const int it = c.bid + stp * c.nblk; if (it >= 3072) break; grow = it >> 2; hh = (it >> 1) & 1; ch2 = it & 1; }
        if (hh != hh_loaded) { __syncthreads(); for (int i = c.tid; i < 16 * 15 * 31; i += NTHR) rp[i] = rpb[hh * (16 * 15 * 31) + i] * 1.44269504089f; hh_loaded = hh; }
        const int row_tok = grow * 64; int s0, L; seq_of(row_tok, s0, L);
        const int rows = L / 64, r = (row_tok - s0) / 64;
        int rs = r - 4; rs = rs < 0 ? 0 : (rs > rows - 8 ? rows - 8 : rs);
        const int kcb0 = ch2 ? 24 : 0;
        const int qc = ch2 * 32 + ql; int qsl = qc - 8; qsl = qsl < 0 ? 0 : (qsl > 48 ? 48 : qsl);
        bf16x8 Qf[2][2]; f32x16 O[2]; float mrun[2], lrun[2];
#pragma unroll
        for (int e = 0; e < 2; ++e) { const int hd = hh * 16 + 2 * c.wave + e;
#pragma unroll
            for (int s = 0; s < 2; ++s) Qf[e][s] = *(const bf16x8*)(qkv + (size_t)(row_tok + qc) * 3072 + hd * 32 + 16 * s + 8 * h);
#pragma unroll
            for (int i = 0; i < 16; ++i) O[e][i] = 0.f;
            mrun[e] = -1e30f; lrun[e] = 0.f; }
        u32x4 pf[10];
        const char* gb = (const char*)qkv; const unsigned goff = ((unsigned)(s0 + kcb0) * 3072u + 1024u + (unsigned)hh * 512u + (unsigned)(c.tid & 63) * 8u) * 2u;
#define NA_ISSUE(KROW) _Pragma("unroll") for (int k = 0; k < 10; ++k) { const int seg = (c.tid >> 6) + 8 * k, kv = seg >= 40 ? 1 : 0, ci = seg - 40 * kv; \
            pf[k] = *(const u32x4*)(gb + (goff + (unsigned)((KROW) * 64 + ci) * 6144u + (unsigned)kv * 2048u)); }
        NA_ISSUE(rs);
        for (int kr = 0; kr < 8; ++kr) {
            const int krow = rs + kr, dr = krow - r + 7;
            __syncthreads();
#pragma unroll
            for (int k = 0; k < 10; ++k) { const int seg = (c.tid >> 6) + 8 * k;
                if (seg < 40) *(LAS u32x4*)(KV + seg * 1024 + (c.tid & 63) * 16) = pf[k];
                else { const int ci = seg - 40, chunk = c.tid & 63; LAS bf16_t* vp = VT + (chunk >> 2) * VH + ((chunk & 3) * 8) * VP + ci; const unsigned wv[4] = {pf[k].x, pf[k].y, pf[k].z, pf[k].w};
#pragma unroll
                    for (int j2 = 0; j2 < 4; ++j2) { vp[(2 * j2) * VP] = (bf16_t)(wv[j2] & 0xffffu); vp[(2 * j2 + 1) * VP] = (bf16_t)(wv[j2] >> 16); } } }
            if (kr < 7) { NA_ISSUE(krow + 1); }
            __syncthreads();
#pragma unroll
            for (int e = 0; e < 2; ++e) {
                const int hl = 2 * c.wave + e; const LAS float* bp = rp + (hl * 15 + dr) * 31;
                f32x16 S0, S1;
#pragma unroll
                for (int i = 0; i < 16; ++i) { S0[i] = 0.f; S1[i] = 0.f; }
#pragma unroll
                for (int s = 0; s < 2; ++s) {
                    const bf16x8 A0 = *(const LAS bf16x8*)(KV + ql * 1024 + hl * 64 + (16 * s + 8 * h) * 2), A1 = *(const LAS bf16x8*)(KV + (8 + ql) * 1024 + hl * 64 + (16 * s + 8 * h) * 2);
                    S0 = __builtin_amdgcn_mfma_f32_32x32x16_bf16(A0, Qf[e][s], S0, 0, 0, 0); S1 = __builtin_amdgcn_mfma_f32_32x32x16_bf16(A1, Qf[e][s], S1, 0, 0, 0); }
                const float sc = 0.17677669529663687f * 1.44269504089f;
                float mloc = -1e30f;
#pragma unroll
                for (int i = 0; i < 16; ++i) { const int ci = (i & 3) + 8 * (i >> 2) + 4 * h;
                    { const int kcol = kcb0 + ci; const bool ok = kcol >= qsl && kcol < qsl + 16; const int dc = ok ? kcol - qc + 15 : 0; const float v = ok ? S0[i] * sc + bp[dc] : -1e30f; S0[i] = v; mloc = fmaxf(mloc, v); }
                    if (i >= 12) {
                      const int kcol = kcb0 + 8 + ci; const bool ok = kcol >= qsl && kcol < qsl + 16; const int dc = ok ? kcol - qc + 15 : 0; const float v = ok ? S1[i] * sc + bp[dc] : -1e30f; S1[i] = v; mloc = fmaxf(mloc, v); } }
                mloc = fmaxf(mloc, __shfl_xor(mloc, 32));
                const float mn = fmaxf(mrun[e], mloc), corr = __builtin_amdgcn_exp2f(mrun[e] - mn); mrun[e] = mn;
                float lsum = 0.f;
#pragma unroll
                for (int i = 0; i < 16; ++i) { O[e][i] *= corr; S0[i] = __builtin_amdgcn_exp2f(S0[i] - mn); lsum += S0[i];
                    if (i >= 12) { S1[i] = __builtin_amdgcn_exp2f(S1[i] - mn); lsum += S1[i]; } else S1[i] = 0.f; }
                lrun[e] = lrun[e] * corr + lsum;
                const LAS bf16_t* vb = VT + hl * VH + ql * VP + 4 * h;
#pragma unroll
                for (int kt = 0; kt < 2; ++kt)
#pragma unroll
                    for (int s = kt; s < 2; ++s) {
                        u32x4 pw;
                        if (kt == 0) { pw.x = cvt_pk_bf16(S0[8 * s], S0[8 * s + 1]); pw.y = cvt_pk_bf16(S0[8 * s + 2], S0[8 * s + 3]); pw.z = cvt_pk_bf16(S0[8 * s + 4], S0[8 * s + 5]); pw.w = cvt_pk_bf16(S0[8 * s + 6], S0[8 * s + 7]); }
                        else { pw.x = cvt_pk_bf16(S1[8 * s], S1[8 * s + 1]); pw.y = cvt_pk_bf16(S1[8 * s + 2], S1[8 * s + 3]); pw.z = cvt_pk_bf16(S1[8 * s + 4], S1[8 * s + 5]); pw.w = cvt_pk_bf16(S1[8 * s + 6], S1[8 * s + 7]); }
                        const u32x2 va = *(const LAS u32x2*)(vb + kt * 8 + 16 * s), vc = *(const LAS u32x2*)(vb + kt * 8 + 16 * s + 8);
                        const u32x4 vq = (u32x4){va.x, va.y, vc.x, vc.y};
                        O[e] = __builtin_amdgcn_mfma_f32_32x32x16_bf16(__builtin_bit_cast(bf16x8, vq), __builtin_bit_cast(bf16x8, pw), O[e], 0, 0, 0);
                    }
            }
        }
#undef NA_ISSUE
#pragma unroll
        for (int e = 0; e < 2; ++e) { const int hd = hh * 16 + 2 * c.wave + e; const float lt = lrun[e] + __shfl_xor(lrun[e], 32), inv = 1.0f / lt;
            bf16_t* op = o + (size_t)(row_tok + qc) * D + hd * 32 + 4 * h;
#pragma unroll
            for (int g = 0; g < 4; ++g) { u32x2 w; w.x = cvt_pk_bf16(O[e][4 * g] * inv, O[e][4 * g + 1] * inv); w.y = cvt_pk_bf16(O[e][4 * g + 2] * inv, O[e][4 * g + 3] * inv); *(u32x2*)(op + 8 * g) = w; } }
    }
    __syncthreads();
}

__device__ __forceinline__ float gelu_tanh(float g) { return 0.5f * g * (1.0f + fast_tanh(0.7978845608028654f * (g + 0.044715f * g * g * g))); }
__device__ __forceinline__ void lru_elem(const Ctx& c, const bf16_t* u, const float* cw, const float* cb, bf16_t* xb, bf16_t* gb) {
    const int ch = (c.tid & 127) * 8, rsub = c.tid >> 7;
    float wgt[4][8], bia[8];
#pragma unroll
    for (int h2 = 0; h2 < 2; ++h2) { const f32x4 b4 = *(const f32x4*)(cb + ch + 4 * h2);
#pragma unroll
        for (int e = 0; e < 4; ++e) bia[4 * h2 + e] = b4[e];
#pragma unroll
        for (int tap = 0; tap < 4; ++tap) { const f32x4 w4 = *(const f32x4*)(cw + tap * D + ch + 4 * h2);
#pragma unroll
            for (int e = 0; e < 4; ++e) wgt[tap][4 * h2 + e] = w4[e]; } }
    for (int slab = c.bid; slab < T / 192; slab += c.nblk) {
        for (int k = 0; k < 48; ++k) {
            const int row = slab * 192 + rsub + 4 * k; int s0, L; seq_of(row, s0, L); const int t = row - s0;
            const bf16_t* p = u + (size_t)row * 2048 + ch;
            const u32x4 gw_ = *(const u32x4*)p; const unsigned gv[4] = {gw_.x, gw_.y, gw_.z, gw_.w};
            u32x4 w;
            w.x = cvt_pk_bf16(gelu_tanh(bflo(gv[0])), gelu_tanh(bfhi(gv[0]))); w.y = cvt_pk_bf16(gelu_tanh(bflo(gv[1])), gelu_tanh(bfhi(gv[1])));
            w.z = cvt_pk_bf16(gelu_tanh(bflo(gv[2])), gelu_tanh(bfhi(gv[2]))); w.w = cvt_pk_bf16(gelu_tanh(bflo(gv[3])), gelu_tanh(bfhi(gv[3])));
            *(u32x4*)(gb + (size_t)row * D + ch) = w;
            float a[8];
#pragma unroll
            for (int e = 0; e < 8; ++e) a[e] = bia[e];
#pragma unroll
            for (int j = 0; j < 4; ++j) { const int tt = t + j - 2; u32x4 xw = (u32x4){0u, 0u, 0u, 0u}; if (tt >= 0 && tt < L) xw = *(const u32x4*)(p + 1024 + (ptrdiff_t)(j - 2) * 2048);
                const unsigned xv[4] = {xw.x, xw.y, xw.z, xw.w};
#pragma unroll
                for (int e = 0; e < 4; ++e) { a[2 * e] += wgt[j][2 * e] * bflo(xv[e]); a[2 * e + 1] += wgt[j][2 * e + 1] * bfhi(xv[e]); } }
            w.x = cvt_pk_bf16(a[0], a[1]); w.y = cvt_pk_bf16(a[2], a[3]); w.z = cvt_pk_bf16(a[4], a[5]); w.w = cvt_pk_bf16(a[6], a[7]);
            *(u32x4*)(xb + (size_t)row * D + ch) = w;
        }
    }
}
constexpr int CL = 64, NCH = T / CL;
#define UNPK8(W_, f) const float f[8] = {bflo((W_).x), bfhi((W_).x), bflo((W_).y), bfhi((W_).y), bflo((W_).z), bfhi((W_).z), bflo((W_).w), bfhi((W_).w)}
__device__ __forceinline__ void lru_scan1(const Ctx& c, const bf16_t* la0, const bf16_t* bb0, const bf16_t* la1, const bf16_t* bb1, f32x2* agg) {
    const int n = NCH * (D / 8);
    for (int i = c.bid * NTHR + c.tid; i < n; i += c.nblk * NTHR) {
        const int ck = i / (D / 8), ch = (i % (D / 8)) * 8; const size_t base = (size_t)ck * CL * D + ch;
#pragma unroll
        for (int dir = 0; dir < 2; ++dir) {
            const bf16_t* la = dir ? la1 : la0; const bf16_t* bb = dir ? bb1 : bb0;
            float sl[8], hb[8];
#pragma unroll
            for (int e = 0; e < 8; ++e) { sl[e] = 0.f; hb[e] = 0.f; }
#pragma unroll 4
            for (int tt = 0; tt < CL; ++tt) { const int t = dir ? CL - 1 - tt : tt; const u32x4 lw = *(const u32x4*)(la + base + (size_t)t * D), bw = *(const u32x4*)(bb + base + (size_t)t * D);
                UNPK8(lw, lf); UNPK8(bw, bf_);
#pragma unroll
                for (int e = 0; e < 8; ++e) { hb[e] = fast_exp(lf[e]) * hb[e] + bf_[e]; sl[e] += lf[e]; } }
            f32x2* ap = agg + (size_t)(ck * 2 + dir) * D + ch;
#pragma unroll
            for (int e = 0; e < 8; e += 2) *(f32x4*)(ap + e) = (f32x4){fast_exp(sl[e]), hb[e], fast_exp(sl[e + 1]), hb[e + 1]};
        }
    }
}
__device__ __forceinline__ void lru_carry(const Ctx& c, const f32x2* agg, float* car) {
    const int n = 5 * 2 * D;
    for (int i = c.bid * NTHR + c.tid; i < n; i += c.nblk * NTHR) {
        const int ch = i % D, dir = (i / D) & 1, sq = i / (2 * D);
        const int ck0 = sq == 0 ? 0 : (TP + (sq - 1) * LS) / CL, nck = sq == 0 ? TP / CL : LS / CL;
        float h = 0.f;
        for (int k0 = 0; k0 < nck; k0 += 16) {
            f32x2 ab[16];
#pragma unroll
            for (int k = 0; k < 16; ++k) { const int kk = dir ? nck - 1 - (k0 + k) : k0 + k; ab[k] = agg[(size_t)((ck0 + kk) * 2 + dir) * D + ch]; }
#pragma unroll
            for (int k = 0; k < 16; ++k) { const int kk = dir ? nck - 1 - (k0 + k) : k0 + k; car[(size_t)((ck0 + kk) * 2 + dir) * D + ch] = h; h = ab[k].x * h + ab[k].y; }
        }
    }
}
__device__ __forceinline__ void lru_scan2(const Ctx& c, const bf16_t* la0, const bf16_t* bb0, const bf16_t* la1, bf16_t* bb1, const float* car, bf16_t* gb) {
    const int n = NCH * (D / 8);
    for (int i = c.bid * NTHR + c.tid; i < n; i += c.nblk * NTHR) {
        const int ck = i / (D / 8), ch = (i % (D / 8)) * 8; const size_t base = (size_t)ck * CL * D + ch;
        float h[8];
        { const f32x4 c0 = *(const f32x4*)(car + (size_t)(ck * 2 + 1) * D + ch), c1 = *(const f32x4*)(car + (size_t)(ck * 2 + 1) * D + ch + 4);
          h[0] = c0[0]; h[1] = c0[1]; h[2] = c0[2]; h[3] = c0[3]; h[4] = c1[0]; h[5] = c1[1]; h[6] = c1[2]; h[7] = c1[3]; }
#pragma unroll 4
        for (int t = CL - 1; t >= 0; --t) { const size_t o = base + (size_t)t * D; const u32x4 lw = *(const u32x4*)(la1 + o), bw = *(const u32x4*)(bb1 + o);
            UNPK8(lw, lf); UNPK8(bw, bf_);
#pragma unroll
            for (int e = 0; e < 8; ++e) h[e] = fast_exp(lf[e]) * h[e] + bf_[e];
            u32x4 w; w.x = cvt_pk_bf16(h[0], h[1]); w.y = cvt_pk_bf16(h[2], h[3]); w.z = cvt_pk_bf16(h[4], h[5]); w.w = cvt_pk_bf16(h[6], h[7]); *(u32x4*)(bb1 + o) = w; }
        { const f32x4 c0 = *(const f32x4*)(car + (size_t)(ck * 2 + 0) * D + ch), c1 = *(const f32x4*)(car + (size_t)(ck * 2 + 0) * D + ch + 4);
          h[0] = c0[0]; h[1] = c0[1]; h[2] = c0[2]; h[3] = c0[3]; h[4] = c1[0]; h[5] = c1[1]; h[6] = c1[2]; h[7] = c1[3]; }
#pragma unroll 4
        for (int t = 0; t < CL; ++t) { const size_t o = base + (size_t)t * D; const u32x4 lw = *(const u32x4*)(la0 + o), bw = *(const u32x4*)(bb0 + o), rw = *(const u32x4*)(bb1 + o), gw_ = *(const u32x4*)(gb + o);
            UNPK8(lw, lf); UNPK8(bw, bf_); UNPK8(rw, rf); UNPK8(gw_, gf);
#pragma unroll
            for (int e = 0; e < 8; ++e) h[e] = fast_exp(lf[e]) * h[e] + bf_[e];
            u32x4 w; w.x = cvt_pk_bf16(gf[0] * (h[0] + rf[0]), gf[1] * (h[1] + rf[1])); w.y = cvt_pk_bf16(gf[2] * (h[2] + rf[2]), gf[3] * (h[3] + rf[3]));
            w.z = cvt_pk_bf16(gf[4] * (h[4] + rf[4]), gf[5] * (h[5] + rf[5])); w.w = cvt_pk_bf16(gf[6] * (h[6] + rf[6]), gf[7] * (h[7] + rf[7])); *(u32x4*)(gb + o) = w; }
    }
}
#undef UNPK8
__device__ __forceinline__ void final_norm(const Ctx& c, const bf16_t* hbf, float* out, const float* rss, const float* g) {
    const size_t n4 = (size_t)T * D / 4;
    for (size_t i = (size_t)c.bid * NTHR + c.tid; i < n4; i += (size_t)c.nblk * NTHR) {
        const int row = (int)(i / (D / 4)), c4 = (int)(i % (D / 4)) * 4; const float rs = pg8::rstd_of(rss, row);
        const u32x2 w = *(const u32x2*)(hbf + i * 4); const f32x4 gv = *(const f32x4*)(g + c4);
        f32x4 v = (f32x4){bflo(w.x), bfhi(w.x), bflo(w.y), bfhi(w.y)}; v = v * rs * gv; *(f32x4*)(out + i * 4) = v;
    }
}

__device__ __forceinline__ const float* ldptr(volatile LAS unsigned* tab, int k) {
    unsigned lo = tab[2 * k], hi = tab[2 * k + 1]; lo = __builtin_amdgcn_readfirstlane(lo); hi = __builtin_amdgcn_readfirstlane(hi);
    return (const float*)(const __attribute__((address_space(1))) float*)(((unsigned long long)hi << 32) | (unsigned long long)lo);
}
#define IN(k) ldptr(tab, (k))
#define WGU1 ((bf16_t*)(ws + WS_WGU1))
#define WD1 ((bf16_t*)(ws + WS_WD1))
#define WGU2 ((bf16_t*)(ws + WS_WGU2))
#define WD2 ((bf16_t*)(ws + WS_WD2))
#define WPG ((bf16_t*)(ws + WS_WPG))
#define WPP ((bf16_t*)(ws + WS_WPP))
#define WMI ((bf16_t*)(ws + WS_WMI))
#define WMO ((bf16_t*)(ws + WS_WMO))
#define WLG ((bf16_t*)(ws + WS_WLG))
#define LSP ((float*)(ws + WS_SMALL))
#define RSS ((float*)(ws + WS_RSS2))
#define AGG ((f32x2*)(ws + WS_AGG))
#define S1 ((bf16_t*)(ws + WS_S1))
#define M1 ((bf16_t*)(ws + WS_M1))
#define M2 ((bf16_t*)(ws + WS_M2))
#define M3 ((bf16_t*)(ws + WS_M3))
#define PBF ((bf16_t*)out + (size_t)T * D)
#define RS ((bf16_t*)out)
#define RSSI(k) (RSS + (size_t)((k) & 1) * T * 16)
#define EPSET(k, v) do { const unsigned long long v_ = (unsigned long long)(v); eptab[2 * (k)] = (unsigned)v_; eptab[2 * (k) + 1] = (unsigned)(v_ >> 32); } while (0)
#define EPBEGIN __syncthreads(); if (c.tid == 0) {
#define EPEND } __syncthreads();
#define GEMM(EpiT, Aptr, Bptr, N_, K_, lda_, ldb_, agrp_) pg8::gemm_phase<EpiT, K_, lda_, ldb_, N_, agrp_>(c.lds, Aptr, Bptr, G, bid, c.tid)

constexpr int NSTEP = 14;
__device__ __forceinline__ void table_init(const Params& P, unsigned char* lds_raw) {
    volatile LAS unsigned* tab0 = (volatile LAS unsigned*)((LAS unsigned char*)lds_raw + TAB_OFF);
    if (threadIdx.x == 0) {
#pragma unroll
        for (int k = 0; k < 48; ++k) { const unsigned long long v = (unsigned long long)P.in[k]; tab0[2 * k] = (unsigned)v; tab0[2 * k + 1] = (unsigned)(v >> 32); }
        { const unsigned long long v = (unsigned long long)P.out; tab0[96] = (unsigned)v; tab0[97] = (unsigned)(v >> 32); }
        { const unsigned long long v = (unsigned long long)P.ws; tab0[98] = (unsigned)v; tab0[99] = (unsigned)(v >> 32); }
    }
    __syncthreads();
}
template <int STEP>
__device__ __forceinline__ void run_step(int step_rt, int layer, unsigned char* lds_raw, bool& did, bool& sync) {
    {
        const int step = STEP >= 0 ? STEP : step_rt, kind = layer % 3, j = layer / 3;
        int tid_ = threadIdx.x, bid = blockIdx.x, G = gridDim.x; LAS unsigned char* lds_ = (LAS unsigned char*)lds_raw;
        asm volatile("" : "+v"(tid_)); asm volatile("" : "+s"(bid)); asm volatile("" : "+s"(G)); asm volatile("" : "+s"(lds_));
        Ctx c; c.tid = tid_; c.lane = c.tid & 63; c.wave = __builtin_amdgcn_readfirstlane(c.tid >> 6); c.bid = bid; c.nblk = G; c.lds = lds_;
        volatile LAS unsigned* tab = (volatile LAS unsigned*)(c.lds + TAB_OFF);
        volatile LAS unsigned* eptab = (volatile LAS unsigned*)(c.lds + TAB_OFF + 1024);
        unsigned char* ws = (unsigned char*)ldptr(tab, 49); float* out = (float*)ldptr(tab, 48);
        bool did = true, sync = true;
        switch (step) {
        case 0: {
            const size_t fo = (size_t)layer * D * DFF;
            convT(c, IN(5) + fo, D, DFF, DFF, IN(4) + layer * D, WGU1, D, 128, 256, 0);
            convT(c, IN(6) + fo, D, DFF, DFF, IN(4) + layer * D, WGU1, D, 128, 256, 128);
            convT(c, IN(7) + fo, DFF, D, D, nullptr, WD1, DFF, D, 0, 0);
            convT(c, IN(10) + fo, D, DFF, DFF, IN(9) + layer * D, WGU2, D, 128, 256, 0);
            convT(c, IN(11) + fo, D, DFF, DFF, IN(9) + layer * D, WGU2, D, 128, 256, 128);
            convT(c, IN(12) + fo, DFF, D, D, nullptr, WD2, DFF, D, 0, 0);
            convT(c, IN(14) + (size_t)layer * D * D, D, D, D, IN(13) + layer * D, WPG, D, D, 0, 0);
            convT(c, IN(15) + (size_t)layer * PLE * D, PLE, D, D, nullptr, WPP, PLE, D, 0, 0);
            const float* lnm = IN(8) + layer * D;
            const float* wi = kind == 0 ? IN(17) + (size_t)j * D * 3 * D : (kind == 1 ? IN(32) : IN(37));
            const float* wo = kind == 0 ? IN(30) + (size_t)j * D * D : (kind == 1 ? IN(35) : IN(46));
            const int ni = kind == 2 ? 2 * D : 3 * D;
            convT(c, wi, D, ni, ni, lnm, WMI, D, ni, 0, 0);
            convT(c, wo, D, D, D, nullptr, WMO, D, D, 0, 0);
            if (kind == 0) { const float* wo_ = IN(28) + (size_t)j * 64 * 2048; for (int i = bid * NTHR + c.tid; i < 64 * 2048; i += G * NTHR) ((bf16_t*)LSP)[i] = f2bf(wo_[(i & 63) * 2048 + (i >> 6)]); }
            if (kind == 2) {
                for (int dg = 0; dg < 16; ++dg)
                    convT(c, IN((dg & 1) ? 41 : 43) + (size_t)(dg >> 1) * 65536, 256, 256, 256, nullptr, WLG + (size_t)(dg >> 1) * 512 * 256, 256, 128, 256, (dg & 1) * 128);
                for (int i = bid * NTHR + c.tid; i < 2 * D; i += G * NTHR) { const float lam = IN(45)[i]; LSP[i] = -8.0f * 0.69314718056f * __builtin_amdgcn_logf(1.0f + fast_exp(-lam)); } }
            if (layer == 0) x_to_bf16(c, IN(0), IN(1), M2, RSSI(0));
        } break;
        case 1: case 10: {
            EPBEGIN EPSET(0, S1); EPSET(1, RSSI(4 * layer + (step == 1 ? 0 : 2))); EPEND
            GEMM(pg8::EpiSwiGLU, (step == 1 ? M2 : RS), (step == 1 ? WGU1 : WGU2), 2 * DFF, D, D, D, false);
            if (step == 1) {
                const int rem = (T / 256) * (2 * DFF / 256) % G;
                if (rem == 0 || bid >= rem) { Ctx c2 = c; c2.bid = rem == 0 ? bid : bid - rem; c2.nblk = rem == 0 ? G : G - rem;
                    p_to_bf16(c2, IN(2) + (size_t)layer * TP * PLE, IN(3) + (size_t)layer * TS * PLE, PBF); } }
        } break;
        case 2: case 9: case 11: {
            const float* mb = step != 9 ? nullptr : (kind == 0 ? IN(31) + j * D : (kind == 1 ? IN(36) : IN(47)));
            const float scale = step == 9 ? 1.0f : 0.5f;
            EPBEGIN EPSET(1, 0); EPSET(2, mb); EPSET(3, (step == 2 ? M2 : RS)); EPSET(5, RS); EPSET(6, RSSI(4 * layer + (step == 2 ? 1 : (step == 9 ? 2 : 3)))); EPSET(7, 0); EPSET(8, __float_as_uint(scale)); EPEND
            if (step == 9) { const bf16_t* A = kind == 0 ? S1 : (kind == 1 ? M1 : M2); GEMM(pg8::EpiResid<0>, A, WMO, D, D, D, D, false); }
            else GEMM(pg8::EpiResid<0>, S1, (step == 2 ? WD1 : WD2), D, DFF, DFF, DFF, false);
            sync = step != 11;
        } break;
        case 3: {
            const float* bias = kind == 0 ? IN(18) + (size_t)j * 3 * D : (kind == 1 ? IN(33) : IN(38));
            EPBEGIN EPSET(0, S1); EPSET(1, RSSI(4 * layer + 1)); EPSET(2, bias); EPSET(3, kind == 2 ? 2 * D : 3 * D); EPEND
            if (kind == 2) GEMM(pg8::EpiProj, RS, WMI, 2 * D, D, D, D, false); else GEMM(pg8::EpiProj, RS, WMI, 3 * D, D, D, D, false);
        } break;
        case 12: {
            EPBEGIN EPSET(0, M1); EPSET(1, 0); EPSET(2, 0); EPSET(3, D); EPEND
            GEMM(pg8::EpiProj, PBF, WPP, D, PLE, PLE, PLE, false);
        } break;
        case 4: {
            if (kind == 0) hy_elem(c, S1, IN(19) + (size_t)j * 9 * D, IN(20) + (size_t)j * 3 * D, M1, M2, M3);
            else if (kind == 1) na_attn(c, S1, IN(34), M1);
            else lru_elem(c, S1, IN(39), IN(40), M1, M2);
        } break;
        case 5: {
            if (kind == 0) {
                bf16_t* FK = S1 + (size_t)T * D;
                for (int hl = 0; hl < 2; ++hl)
                    hy_filter(c, hl ? LS : TP, hl ? (size_t)D * 2 * TP : (size_t)0, IN(21) + j * 33 * 64, IN(22) + j * 64, IN(23) + j * 4096, IN(24) + j * 64, IN(25) + j * 4096, IN(26) + j * 64, IN(27) + j * 64, (const bf16_t*)LSP, IN(29) + j * D, FK);
            } else if (kind == 2) {
                EPBEGIN EPSET(0, M1); EPSET(1, S1); EPSET(2, S1 + 2 * (size_t)T * D); EPSET(3, S1 + (size_t)T * D); EPSET(4, M3); EPSET(5, IN(44)); EPSET(6, IN(42)); EPSET(7, LSP); EPEND
                GEMM(pg8::EpiLruGates, M1, WLG, 4096, 256, D, 256, true);
            } else did = false;
        } break;
        case 6: {
            if (kind == 0) hy_longconv(c, M3, S1 + (size_t)T * D, S1 + 2 * (size_t)T * D);
            else if (kind == 2) lru_scan1(c, S1, S1 + (size_t)T * D, S1 + 2 * (size_t)T * D, M3, AGG);
            else did = false;
        } break;
        case 7: { if (kind == 2) lru_carry(c, AGG, (float*)(ws + WS_CAR)); else if (kind == 0) hy_final(c, S1 + 2 * (size_t)T * D, M1, M2, IN(29) + j * D, S1); else did = false; } break;
        case 8: { if (kind == 2) lru_scan2(c, S1, S1 + (size_t)T * D, S1 + 2 * (size_t)T * D, M3, (const float*)(ws + WS_CAR), M2); else did = false; } break;
        default: {
            EPBEGIN EPSET(1, RSSI(4 * layer + 3)); EPSET(2, 0); EPSET(3, RS); EPSET(5, M2); EPSET(6, RSSI(4 * layer + 4)); EPSET(7, M1); EPSET(8, 0); EPEND
            GEMM(pg8::EpiResid<1>, RS, WPG, D, D, D, D, false);
        } break;
        }
    }
}
template <int STEP>
__global__ void __launch_bounds__(NTHR, 2) step_kernel(Params P, int layer) {
    extern __shared__ __attribute__((aligned(16))) unsigned char lds_raw[];
    table_init(P, lds_raw);
    bool did = true, sync = true;
    run_step<STEP>(STEP, layer, lds_raw, did, sync);
}
__global__ void __launch_bounds__(NTHR, 2) final_kernel(Params P) {
    Ctx c; c.tid = threadIdx.x; c.lane = c.tid & 63; c.wave = __builtin_amdgcn_readfirstlane(c.tid >> 6); c.bid = blockIdx.x; c.nblk = gridDim.x; c.lds = nullptr;
    final_norm(c, (const bf16_t*)(P.ws + WS_M2), P.out, (const float*)(P.ws + WS_RSS2), P.in[16]);
}
__global__ void __launch_bounds__(NTHR, 2) trunk_fwd(Params P) {
    extern __shared__ __attribute__((aligned(16))) unsigned char lds_raw[];
    cg::grid_group grid = cg::this_grid();
    {   volatile LAS unsigned* st0 = (volatile LAS unsigned*)((LAS unsigned char*)lds_raw + TAB_OFF + 2048);
        if (threadIdx.x == 0) { st0[0] = 0u; st0[1] = 0u; (void)xb_add(&((unsigned*)(P.ws + WS_BAR))[XB_XCNT(xb_xcc_id())], 1u); } }
    table_init(P, lds_raw);
#pragma nounroll
    for (int ph = 0; ph < 4 * NSTEP; ++ph) {
        bool did = true, sync = true;
        run_step<-1>(ph % NSTEP, ph / NSTEP, lds_raw, did, sync);
#if PROBE
        {   const int st_ = ph % NSTEP; bool rep = false;
            if ((PROBE & 1) && (st_ == 1 || st_ == 10)) rep = true;
            if ((PROBE & 2) && st_ == 6 && (ph / NSTEP) % 3 == 0) rep = true;
            if ((PROBE & 8) && st_ == 0) rep = true;
            if ((PROBE & 16) && st_ == 3) rep = true;
            if ((PROBE & 32) && (st_ == 4 || st_ == 5) ) rep = true;
            { const int kd_ = (ph / NSTEP) % 3;
              if ((PROBE & 64) && st_ == 4 && kd_ == 0) rep = true;
              if ((PROBE & 128) && st_ == 5 && kd_ == 0) rep = true;
              if ((PROBE & 256) && st_ == 4 && kd_ == 1) rep = true;
              if ((PROBE & 512) && st_ == 4 && kd_ == 2) rep = true;
              if ((PROBE & 1024) && st_ == 5 && kd_ == 2) rep = true;
              if ((PROBE & 2048) && st_ == 6 && kd_ == 2) rep = true;
              if ((PROBE & 4096) && st_ == 7 && kd_ == 0) rep = true; }
            if (rep) { if (did && sync) xcd_barrier((unsigned*)(P.ws + WS_BAR), (volatile LAS unsigned*)((LAS unsigned char*)lds_raw + TAB_OFF + 2048)); run_step<-1>(ph % NSTEP, ph / NSTEP, lds_raw, did, sync); }
            if ((PROBE & 4) && did && sync) xcd_barrier((unsigned*)(P.ws + WS_BAR), (volatile LAS unsigned*)((LAS unsigned char*)lds_raw + TAB_OFF + 2048)); }
#endif
        if (did && sync) {
            if (ph == 0) grid.sync();
            else xcd_barrier((unsigned*)(P.ws + WS_BAR), (volatile LAS unsigned*)((LAS unsigned char*)lds_raw + TAB_OFF + 2048));
        }
    }
    {   Ctx c; c.tid = threadIdx.x; c.lane = c.tid & 63; c.wave = __builtin_amdgcn_readfirstlane(c.tid >> 6); c.bid = blockIdx.x; c.nblk = gridDim.x; c.lds = (LAS unsigned char*)lds_raw;
        final_norm(c, (const bf16_t*)(P.ws + WS_M2), P.out, (const float*)(P.ws + WS_RSS2), P.in[16]); }
}

#ifndef MEGA
#define MEGA 1
#endif
template <int STEP> static void launch_step(const Params& p, int layer, int grid, hipStream_t stream) {
    static bool attr = false;
    if (!attr) { (void)hipFuncSetAttribute((const void*)step_kernel<STEP>, hipFuncAttributeMaxDynamicSharedMemorySize, LDS_BYTES); attr = true; }
    hipLaunchKernelGGL(step_kernel<STEP>, dim3(grid), dim3(NTHR), LDS_BYTES, stream, p, layer);
}
extern "C" void kernel_launch(void* const* d_in, const int* in_sizes, int n_in, void* d_out, int out_size, void* d_ws, size_t ws_size, hipStream_t stream) {
    static int grid = 0;
    if (grid == 0) {
        if (n_in != 48 || out_size != T * D || ws_size < WS_END) { fprintf(stderr, "kernel_launch: unexpected shapes n_in %d out %d ws %zu (need %zu)\n", n_in, out_size, ws_size, (size_t)WS_END); grid = -1; return; }
        int dev = 0, cus = 0;
        (void)hipGetDevice(&dev); (void)hipDeviceGetAttribute(&cus, hipDeviceAttributeMultiprocessorCount, dev);
        if (hipFuncSetAttribute((const void*)trunk_fwd, hipFuncAttributeMaxDynamicSharedMemorySize, LDS_BYTES) != hipSuccess) { fprintf(stderr, "kernel_launch: hipFuncSetAttribute failed\n"); grid = -1; return; }
        (void)hipGetLastError();
        grid = cus;
    }
    if (grid < 0) return;
    Params p{};
    for (int i = 0; i < 48; ++i) p.in[i] = (const float*)d_in[i];
    p.out = (float*)d_out; p.ws = (unsigned char*)d_ws;
#if MEGA
    (void)hipMemsetAsync((unsigned char*)d_ws + WS_BAR, 0, XCD_BAR_WORDS * 4, stream);
    void* args[] = {&p};
    hipError_t e = hipLaunchCooperativeKernel((const void*)trunk_fwd, dim3(grid), dim3(NTHR), args, LDS_BYTES, stream);
    if (e != hipSuccess) fprintf(stderr, "cooperative launch failed: %s (grid %d)\n", hipGetErrorString(e), grid);
#else
    for (int layer = 0; layer < 4; ++layer) {
        const int kind = layer % 3;
        launch_step<0>(p, layer, grid, stream); launch_step<1>(p, layer, grid, stream); launch_step<2>(p, layer, grid, stream); launch_step<3>(p, layer, grid, stream);
        launch_step<4>(p, layer, grid, stream);
        if (kind != 1) { launch_step<5>(p, layer, grid, stream); launch_step<6>(p, layer, grid, stream); }
        if (kind != 1) launch_step<7>(p, layer, grid, stream);
        if (kind == 2) launch_step<8>(p, layer, grid, stream);
        launch_step<9>(p, layer, grid, stream); launch_step<10>(p, layer, grid, stream); launch_step<11>(p, layer, grid, stream); launch_step<12>(p, layer, grid, stream); launch_step<13>(p, layer, grid, stream);
    }
    hipLaunchKernelGGL(final_kernel, dim3(grid), dim3(NTHR), 0, stream, p);
#endif
}
```
